# Optimizing an MI355X kernel written in HIP

```python
import jax, jax.numpy as jnp
from jax import lax
import numpy as np

D_MODEL = 1024
BATCH = 32
SEQ = 2048
DEPTH = 4

N_FOURIER_GROUPS = 8
D_FOURIER = D_MODEL // 2
FOURIER_GROUP_DIM = D_FOURIER // N_FOURIER_GROUPS
CHUNK = 128
N_SGU_HEADS = 8
D_SGU = D_MODEL
SGU_HEAD_DIM = D_SGU // N_SGU_HEADS
IN_COLS = D_FOURIER + 2 * D_SGU + 2 * D_MODEL
D_FF = 4 * D_MODEL
EPS = 1e-6

kernel_name = "hybrid_fnet_gmlp_gated_encoder"


def rms_norm(x, g):
    xf = x.astype(jnp.float32)
    y = xf * lax.rsqrt(jnp.mean(xf * xf, axis=-1, keepdims=True) + EPS)
    return (y * g.astype(jnp.float32)).astype(x.dtype)


def layer_norm(x, g, b):
    xf = x.astype(jnp.float32)
    mu = jnp.mean(xf, axis=-1, keepdims=True)
    xc = xf - mu
    y = xc * lax.rsqrt(jnp.mean(xc * xc, axis=-1, keepdims=True) + EPS)
    return (y * g.astype(jnp.float32) + b.astype(jnp.float32)).astype(x.dtype)


def fourier_mixer(a):
    bsz, seq, _ = a.shape
    ag = a.reshape(bsz, seq, N_FOURIER_GROUPS, FOURIER_GROUP_DIM).astype(jnp.float32)
    y = jnp.fft.fft2(ag, axes=(1, 3), norm="ortho").real
    return y.reshape(bsz, seq, D_FOURIER).astype(a.dtype)


def spatial_gating(u, v, ln_g, ln_b, w_s, b_s):
    bsz, seq, _ = v.shape
    n_chunks = seq // CHUNK
    vn = layer_norm(v, ln_g, ln_b).reshape(bsz, n_chunks, CHUNK, N_SGU_HEADS, SGU_HEAD_DIM)
    mixed = jnp.einsum('hqp,bnphd->bnqhd', w_s, vn) + b_s.T[None, None, :, :, None]
    return u * mixed.reshape(bsz, seq, D_SGU)


def setup_inputs(seed: int = 0) -> dict:
    key = jax.random.key(seed)
    ks = jax.random.split(key, 16)
    f32 = jnp.float32
    nrm = lambda k, shape, scale: jax.random.normal(k, shape, f32) * scale
    return {
        "x": nrm(ks[0], (BATCH, SEQ, D_MODEL), 1.0),
        "g_mix": 1.0 + nrm(ks[1], (DEPTH, D_MODEL), 0.02),
        "w_in": nrm(ks[2], (DEPTH, D_MODEL, IN_COLS), D_MODEL ** -0.5),
        "w_a": nrm(ks[3], (DEPTH, D_FOURIER, D_MODEL), D_FOURIER ** -0.5),
        "ln_v_g": 1.0 + nrm(ks[4], (DEPTH, D_SGU), 0.02),
        "ln_v_b": nrm(ks[5], (DEPTH, D_SGU), 0.02),
        "w_s": nrm(ks[6], (DEPTH, N_SGU_HEADS, CHUNK, CHUNK), CHUNK ** -0.5),
        "b_s": 1.0 + nrm(ks[7], (DEPTH, N_SGU_HEADS, CHUNK), 0.1),
        "w_b": nrm(ks[8], (DEPTH, D_SGU, D_MODEL), D_SGU ** -0.5),
        "w_out": nrm(ks[9], (DEPTH, D_MODEL, D_MODEL), D_MODEL ** -0.5),
        "g_mlp": 1.0 + nrm(ks[10], (DEPTH, D_MODEL), 0.02),
        "w_up": nrm(ks[11], (DEPTH, D_MODEL, D_FF), D_MODEL ** -0.5),
        "w_down": nrm(ks[12], (DEPTH, D_FF, D_MODEL), D_FF ** -0.5),
        "g_final": 1.0 + nrm(ks[13], (D_MODEL,), 0.02),
    }


def reference(x, g_mix, w_in, w_a, ln_v_g, ln_v_b, w_s, b_s, w_b, w_out,
              g_mlp, w_up, w_down, g_final):
    c_a = D_FOURIER
    c_u = c_a + D_SGU
    c_v = c_u + D_SGU
    c_ga = c_v + D_MODEL
    for l in range(DEPTH):
        h = rms_norm(x, g_mix[l])
        z = jnp.einsum('bsd,dc->bsc', h, w_in[l])
        a_in = z[..., :c_a]
        uv = jax.nn.gelu(z[..., c_a:c_v])
        u, v = uv[..., :D_SGU], uv[..., D_SGU:]
        gate_a = jax.nn.sigmoid(z[..., c_v:c_ga])
        gate_b = jax.nn.sigmoid(z[..., c_ga:])
        y_a = jnp.einsum('bsc,cd->bsd', fourier_mixer(a_in), w_a[l])
        y_b = jnp.einsum('bsc,cd->bsd', spatial_gating(u, v, ln_v_g[l], ln_v_b[l], w_s[l], b_s[l]), w_b[l])
        merged = gate_a * y_a + gate_b * y_b
        x = x + jnp.einsum('bsd,de->bse', merged, w_out[l])
        h2 = rms_norm(x, g_mlp[l])
        f = jnp.square(jax.nn.relu(jnp.einsum('bsd,df->bsf', h2, w_up[l])))
        x = x + jnp.einsum('bsf,fd->bsd', f, w_down[l])
    return rms_norm(x, g_final)
```

```cpp
#include <hip/hip_runtime.h>
#include <hip/hip_cooperative_groups.h>
#include <cstdio>
#include <cstdint>
namespace cg = cooperative_groups;

#define LAS __attribute__((address_space(3)))
typedef unsigned short bf16_t;
typedef short bf16x8 __attribute__((ext_vector_type(8)));
typedef float f32x4 __attribute__((ext_vector_type(4)));
typedef unsigned u32x4 __attribute__((ext_vector_type(4)));
typedef unsigned u32x2 __attribute__((ext_vector_type(2)));

constexpr int T_TOK = 65536, DM = 1024, SEQ = 2048, NBATCH = 32, DEPTH = 4, DFF = 4096, INC = 4608;
constexpr float EPS = 1e-6f;

constexpr size_t SZ_TD = (size_t)T_TOK * DM * 2;
constexpr size_t WS_XB   = 0;
constexpr size_t WS_AINT = WS_XB + SZ_TD;
constexpr size_t WS_VT   = WS_AINT + SZ_TD / 2;
constexpr size_t WS_U    = WS_VT + SZ_TD;
constexpr size_t WS_GA   = WS_U + SZ_TD;
constexpr size_t WS_GB   = WS_GA + SZ_TD;
constexpr size_t WS_YA   = WS_GB + SZ_TD;
constexpr size_t WS_WIN  = WS_YA + SZ_TD;
constexpr size_t WS_WACS = WS_WIN + (size_t)DEPTH * INC * DM * 2;
constexpr size_t WS_WB   = WS_WACS + (size_t)DEPTH * DM * DM * 2;
constexpr size_t WS_WOUT = WS_WB + (size_t)DEPTH * DM * DM * 2;
constexpr size_t WS_WUP  = WS_WOUT + (size_t)DEPTH * DM * DM * 2;
constexpr size_t WS_WDN  = WS_WUP + (size_t)DEPTH * DFF * DM * 2;
constexpr size_t WS_WS   = WS_WDN + (size_t)DEPTH * DFF * DM * 2;
constexpr size_t WS_CS   = WS_WS + (size_t)DEPTH * 8 * 128 * 128 * 2;
constexpr size_t WS_RSA  = WS_CS + (size_t)SEQ * SEQ * 2;
constexpr size_t WS_RSB  = WS_RSA + (size_t)T_TOK * 16 * 4;
constexpr size_t WS_BAR  = WS_RSB + (size_t)T_TOK * 16 * 4;
constexpr size_t WS_BAR_BYTES = 16384;
constexpr size_t WS_END  = WS_BAR + WS_BAR_BYTES;
constexpr size_t WS_F    = WS_AINT;
constexpr size_t WS_MRG  = WS_VT;

__device__ __forceinline__ unsigned cvt_pk_bf16(float lo, float hi) { unsigned r; asm volatile("v_cvt_pk_bf16_f32 %0, %1, %2" : "=v"(r) : "v"(lo), "v"(hi)); return r; }
__device__ __forceinline__ void st_nt(void* p, const u32x4& v) { __builtin_nontemporal_store(v, (u32x4*)p); }
__device__ __forceinline__ unsigned dpp_swap1(unsigned v) { return (unsigned)__builtin_amdgcn_update_dpp(0, (int)v, 0xB1, 0xf, 0xf, true); }
__device__ __forceinline__ void pair_lines(bool odd, const u32x4& w0, const u32x4& w1, u32x4& va, u32x4& vb) {
    u32x4 snd, rcv;
    snd.x = odd ? w0.x : w1.x; snd.y = odd ? w0.y : w1.y; snd.z = odd ? w0.z : w1.z; snd.w = odd ? w0.w : w1.w;
    rcv.x = dpp_swap1(snd.x); rcv.y = dpp_swap1(snd.y); rcv.z = dpp_swap1(snd.z); rcv.w = dpp_swap1(snd.w);
    va.x = odd ? rcv.x : w0.x; va.y = odd ? rcv.y : w0.y; va.z = odd ? rcv.z : w0.z; va.w = odd ? rcv.w : w0.w;
    vb.x = odd ? w1.x : rcv.x; vb.y = odd ? w1.y : rcv.y; vb.z = odd ? w1.z : rcv.z; vb.w = odd ? w1.w : rcv.w;
}
__device__ __forceinline__ float bf_lo(unsigned w) { return __uint_as_float(w << 16); }
__device__ __forceinline__ float bf_hi(unsigned w) { return __uint_as_float(w & 0xffff0000u); }
__device__ __forceinline__ float sigmoid_f(float a) { return __builtin_amdgcn_rcpf(1.0f + __builtin_amdgcn_exp2f(-1.4426950408889634f * a)); }
__device__ __forceinline__ float gelu_tanh_f(float x) { const float t = 1.5957691216057308f * (x + 0.044715f * x * x * x); return x * sigmoid_f(t); }

namespace pg8 {
constexpr int BM = 256, BK = 64, HALF = 128, HTB = HALF * BK * 2, STAGE_BYTES = 8 * HTB, NXCD = 8, WGM = 8;
__host__ __device__ __forceinline__ int lds_byte(int r, int c) { const int st = (r >> 4) * 2 + (c >> 5), rr = r & 15, cc = c & 31, ob = rr * 64 + cc * 2; return st * 1024 + (ob ^ (((ob >> 9) & 1) << 5)); }
__host__ __device__ __forceinline__ void stage_rc(int b, int& R, int& C) { const int st = b / 1024, sb = b % 1024, swz = sb ^ (((sb >> 9) & 1) << 5); R = (st >> 1) * 16 + swz / 64; C = (st & 1) * 32 + (swz % 64) / 2; }
__host__ __device__ __forceinline__ int perm32(int rho) { const int n = rho >> 4, i = rho & 15; return 8 * (i >> 2) + 4 * n + (i & 3); }

struct Unit { int pm, pn; };
struct Gemm { const bf16_t* A; const bf16_t* Bt; const bf16_t* A2; const bf16_t* Bt2; };

template <int M, int N> struct StaticOrder {
    static constexpr int nM = M / BM, nN = N / BM, nwg = nM * nN;
    int G, c;
    __device__ void init(int G_, int c_) { G = G_; c = c_; }
    __device__ bool next(int i, Unit& u) const {
        const int L = i * G + c; if (L >= nwg) return false;
        int wgid = L; { constexpr int q = nwg / NXCD, r = nwg % NXCD; const int xcd = wgid % NXCD, off = wgid / NXCD; wgid = (xcd < r ? xcd * (q + 1) : r * (q + 1) + (xcd - r) * q) + off; }
        constexpr int nig = WGM * nN; const int gid = wgid / nig, fm = gid * WGM, gsz = (nM - fm) < WGM ? (nM - fm) : WGM;
        u.pm = fm + ((wgid % nig) % gsz); u.pn = (wgid % nig) / gsz; return true;
    }
};

template <class Epi, bool ALIGN_EPI, int M, int N, int K, int LD = K, int KSPLIT = K / BK>
__device__ __forceinline__ void gemm_phase(LAS unsigned char* lds, const Gemm g, const StaticOrder<M, N>& S, const Epi& E) {
    int tid_ = threadIdx.x; asm volatile("" : "+v"(tid_));
    const int tid = tid_, wid = __builtin_amdgcn_readfirstlane(tid >> 6), lane = tid & 63, wr = wid >> 2, wc = wid & 3, fr = lane & 15, fq = lane >> 4;
    constexpr int nt = K / BK;
    unsigned voffA, voffB;
    { int R, C; stage_rc(tid * 16, R, C); const int Rb = Epi::PERM ? (64 * (R >> 5) + perm32(R & 31)) : R;
      voffA = (unsigned)(R * LD + C) * 2u; voffB = (unsigned)(Rb * LD + C) * 2u; }
    constexpr size_t bhs = Epi::PERM ? (size_t)32 * LD * 2 : (size_t)HALF * LD * 2;
    constexpr size_t bps = Epi::PERM ? (size_t)128 * LD * 2 : (size_t)64 * LD * 2;
    constexpr size_t kstep = (size_t)(BK * 2);
    constexpr size_t hstep = (size_t)HALF * LD * 2;
    constexpr size_t tstep = 2 * hstep;
    const unsigned ldsw = (unsigned)wid * 1024u;
    const int aoff = lds_byte(wr * 64 + fr, fq * 8), boff = lds_byte(wc * 32 + fr, fq * 8);
#define PG8_SA(b, h) (((b) * 2 + (h)) * HTB)
#define PG8_SB(b, h) ((4 + (b) * 2 + (h)) * HTB)
#define PG8_STAGE(bufoff, gbase, voff) do { _Pragma("unroll") for (int _i = 0; _i < 2; ++_i) \
        __builtin_amdgcn_global_load_lds((const unsigned*)((const char*)(gbase) + (size_t)_i * (64 * LD * 2) + (voff)), (LAS unsigned*)(lds + (bufoff) + ldsw + _i * 8192), 16, 0, 0); } while (0)
#define PG8_STAGEB(bufoff, gbase, voff) do { _Pragma("unroll") for (int _i = 0; _i < 2; ++_i) \
        __builtin_amdgcn_global_load_lds((const unsigned*)((const char*)(gbase) + (size_t)_i * bps + (voff)), (LAS unsigned*)(lds + (bufoff) + ldsw + _i * 8192), 16, 0, 0); } while (0)
#define PG8_LDA(dst, b, h) do { _Pragma("unroll") for (int m = 0; m < 4; ++m) _Pragma("unroll") for (int k = 0; k < 2; ++k) dst[m][k] = *(const LAS bf16x8*)(lds + PG8_SA(b, h) + aoff + m * 2048 + k * 1024); } while (0)
#define PG8_LDB(dst, b, h) do { _Pragma("unroll") for (int n = 0; n < 2; ++n) _Pragma("unroll") for (int k = 0; k < 2; ++k) dst[n][k] = *(const LAS bf16x8*)(lds + PG8_SB(b, h) + boff + n * 2048 + k * 1024); } while (0)
#define PG8_MMA(ai, bj, At, Bt) do { __builtin_amdgcn_s_setprio(1); _Pragma("unroll") for (int m = 0; m < 4; ++m) _Pragma("unroll") for (int n = 0; n < 2; ++n) _Pragma("unroll") for (int k = 0; k < 2; ++k) \
        acc[ai][bj][m][n] = Epi::SWAP ? __builtin_amdgcn_mfma_f32_16x16x32_bf16(At[m][k], Bt[n][k], acc[ai][bj][m][n], 0, 0, 0) \
                                      : __builtin_amdgcn_mfma_f32_16x16x32_bf16(Bt[n][k], At[m][k], acc[ai][bj][m][n], 0, 0, 0); __builtin_amdgcn_s_setprio(0); } while (0)
#define PG8_WAIT_V(n) asm volatile("s_waitcnt vmcnt(" #n ")" ::: "memory")
#define PG8_WAIT_L(n) asm volatile("s_waitcnt lgkmcnt(" #n ")" ::: "memory")
#define PG8_BAR __builtin_amdgcn_s_barrier()
#define PG8_SCHED __builtin_amdgcn_sched_barrier(0)
    Unit cur, nxt; int ui = 0;
    if (!S.next(0, cur)) return;
    f32x4 acc[2][2][4][2];
#pragma unroll
    for (int a = 0; a < 2; ++a)
#pragma unroll
        for (int b = 0; b < 2; ++b)
#pragma unroll
            for (int m = 0; m < 4; ++m)
#pragma unroll
                for (int n = 0; n < 2; ++n) acc[a][b][m][n] = (f32x4){0.f, 0.f, 0.f, 0.f};
    bf16x8 At[4][2], B0[2][2], B1[2][2];
    constexpr bool SPLIT = KSPLIT < nt;
    const char* cA = (const char*)g.A + (size_t)cur.pm * tstep; const char* cB = (const char*)g.Bt + (size_t)cur.pn * tstep;
    const char* cA2 = SPLIT ? (const char*)g.A2 + (size_t)cur.pm * tstep : cA; const char* cB2 = SPLIT ? (const char*)g.Bt2 + (size_t)cur.pn * tstep : cB;
#define PG8_TA(tt) ((SPLIT && (tt) >= KSPLIT) ? cA2 + (size_t)((tt) - KSPLIT) * kstep : cA + (size_t)(tt) * kstep)
#define PG8_TB(tt) ((SPLIT && (tt) >= KSPLIT) ? cB2 + (size_t)((tt) - KSPLIT) * kstep : cB + (size_t)(tt) * kstep)
    PG8_STAGEB(PG8_SB(0, 0), cB, voffB); PG8_STAGEB(PG8_SB(0, 1), cB + bhs, voffB); PG8_STAGE(PG8_SA(0, 0), cA, voffA); PG8_STAGE(PG8_SA(0, 1), cA + hstep, voffA);
    if (wr == 1) PG8_BAR;
    PG8_WAIT_V(2); PG8_BAR;
    PG8_STAGEB(PG8_SB(1, 0), cB + kstep, voffB); PG8_STAGE(PG8_SA(1, 0), cA + kstep, voffA); PG8_STAGEB(PG8_SB(1, 1), cB + bhs + kstep, voffB);
    PG8_WAIT_V(6); PG8_BAR;
    for (;;) {
        const bool has_next = S.next(ui + 1, nxt);
        const char* nA = has_next ? (const char*)g.A + (size_t)nxt.pm * tstep : cA; const char* nB = has_next ? (const char*)g.Bt + (size_t)nxt.pn * tstep : cB;
        for (int t = 0; t < nt; t += 2) {
            const bool last = (t == nt - 2);
            const bool first = (t == 0) && (ui > 0);
            const char* a1 = PG8_TA(t + 1);
            const char* a2 = last ? nA : PG8_TA(t + 2); const char* b2 = last ? nB : PG8_TB(t + 2);
            const char* a3 = a2 + kstep; const char* b3 = b2 + kstep;
            PG8_LDB(B0, 0, 0); PG8_LDB(B1, 0, 1); PG8_SCHED; PG8_LDA(At, 0, 0); if (!first) { PG8_STAGE(PG8_SA(1, 1), a1 + hstep, voffA); PG8_WAIT_V(8); }
            PG8_WAIT_L(0); PG8_BAR; PG8_MMA(0, 0, At, B0); PG8_MMA(0, 1, At, B1); PG8_BAR; PG8_SCHED;
            PG8_LDA(At, 0, 1); PG8_STAGEB(PG8_SB(0, 0), b2, voffB); PG8_STAGEB(PG8_SB(0, 1), b2 + bhs, voffB); PG8_STAGE(PG8_SA(0, 0), a2, voffA);
            if (!first) PG8_WAIT_V(8); PG8_WAIT_L(0); PG8_BAR; PG8_MMA(1, 0, At, B0); PG8_MMA(1, 1, At, B1); PG8_BAR; PG8_SCHED;
            PG8_LDB(B0, 1, 0); PG8_LDB(B1, 1, 1); PG8_SCHED; PG8_LDA(At, 1, 0); PG8_STAGE(PG8_SA(0, 1), a2 + hstep, voffA);
            if (!first) PG8_WAIT_V(8); PG8_WAIT_L(0); PG8_BAR; PG8_MMA(0, 0, At, B0); PG8_MMA(0, 1, At, B1); PG8_BAR; PG8_SCHED;
            PG8_LDA(At, 1, 1); PG8_STAGEB(PG8_SB(1, 0), b3, voffB); PG8_STAGEB(PG8_SB(1, 1), b3 + bhs, voffB); PG8_STAGE(PG8_SA(1, 0), a3, voffA);
            if (!first) PG8_WAIT_V(8); PG8_WAIT_L(0); PG8_BAR; PG8_MMA(1, 0, At, B0); PG8_MMA(1, 1, At, B1); PG8_BAR; PG8_SCHED;
            if constexpr (SPLIT) { if (t + 2 == KSPLIT) { int fr_e = fr, fq_e = fq; asm volatile("" : "+v"(fr_e), "+v"(fq_e)); E.mid(acc, cur, wr, wc, fr_e, fq_e); } }
        }
        if constexpr (ALIGN_EPI) { if (wr == 0) PG8_BAR; }
        if (has_next) PG8_STAGE(PG8_SA(1, 1), nA + kstep + hstep, voffA);
        { int fr_e = fr, fq_e = fq; asm volatile("" : "+v"(fr_e), "+v"(fq_e));
          E(acc, cur, wr, wc, fr_e, fq_e); }
        if (!has_next) break;
#pragma unroll
        for (int a = 0; a < 2; ++a)
#pragma unroll
            for (int b = 0; b < 2; ++b)
#pragma unroll
                for (int m = 0; m < 4; ++m)
#pragma unroll
                    for (int n = 0; n < 2; ++n) acc[a][b][m][n] = (f32x4){0.f, 0.f, 0.f, 0.f};
        cur = nxt; cA = nA; cB = nB; ++ui;
        if constexpr (SPLIT) { cA2 = (const char*)g.A2 + (size_t)cur.pm * tstep; cB2 = (const char*)g.Bt2 + (size_t)cur.pn * tstep; }
        if constexpr (ALIGN_EPI) { if (wr == 1) PG8_BAR; }
    }
    PG8_WAIT_V(0);
    if constexpr (!ALIGN_EPI) { if (wr == 0) PG8_BAR; }
    PG8_BAR;
#undef PG8_TA
#undef PG8_TB
#undef PG8_STAGEB
#undef PG8_SA
#undef PG8_SB
#undef PG8_STAGE
#undef PG8_LDA
#undef PG8_LDB
#undef PG8_MMA
#undef PG8_WAIT_V
#undef PG8_WAIT_L
#undef PG8_BAR
#undef PG8_SCHED
}
}

typedef f32x4 AccT[2][2][4][2];

struct Params { const float* in[14]; float* out; unsigned char* ws; };
typedef const Params __attribute__((address_space(4))) * KParams;
__device__ __forceinline__ KParams get_params() {
    KParams p = (KParams)__builtin_amdgcn_kernarg_segment_ptr();
    asm volatile("" : "+s"(p));
    return p;
}


__device__ __forceinline__ void rows_rs8(const float* rowss, int row0  , int fq, float (&rs)[8]) {
    f32x4 t[8];
#pragma unroll
    for (int g = 0; g < 8; ++g) t[g] = *(const f32x4*)(rowss + (size_t)(row0 + (g >> 2) * 128 + (g & 3) * 16) * 16 + fq * 4);
#pragma unroll
    for (int g = 0; g < 8; ++g) {
        float s = (t[g][0] + t[g][1]) + (t[g][2] + t[g][3]);
        s += __shfl_xor(s, 16); s += __shfl_xor(s, 32);
        rs[g] = __builtin_amdgcn_rsqf(s * (1.0f / 1024.0f) + EPS);
    }
    asm volatile("s_waitcnt vmcnt(0)" ::: "memory");
}
__device__ __forceinline__ float dpp_row_sum16(float s) {
    s += __builtin_bit_cast(float, __builtin_amdgcn_update_dpp(0, __builtin_bit_cast(int, s), 0x128, 0xf, 0xf, false));
    s += __builtin_bit_cast(float, __builtin_amdgcn_update_dpp(0, __builtin_bit_cast(int, s), 0x124, 0xf, 0xf, false));
    s += __builtin_bit_cast(float, __builtin_amdgcn_update_dpp(0, __builtin_bit_cast(int, s), 0x122, 0xf, 0xf, false));
    s += __builtin_bit_cast(float, __builtin_amdgcn_update_dpp(0, __builtin_bit_cast(int, s), 0x121, 0xf, 0xf, false));
    return s;
}

struct EpiIn {
    static constexpr bool PERM = true, SWAP = false;
    __device__ __forceinline__ void operator()(const AccT& acc, const pg8::Unit& u, int wr, int wc, int fr, int fq) const {
        unsigned char* ws = get_params()->ws; bf16_t* U = (bf16_t*)(ws + WS_U); const float* rowss = (const float*)(ws + WS_RSA);
        const int t = u.pn >> 2;
        bf16_t* base = U + (size_t)t * T_TOK * DM;
        const int col0 = (u.pn & 3) * 256 + wc * 64 + 8 * fq;
        const int row0 = u.pm * 256 + wr * 64 + fr;
        float rsv[8]; rows_rs8(rowss, row0, fq, rsv);
#pragma unroll
        for (int ai = 0; ai < 2; ++ai)
#pragma unroll
            for (int m = 0; m < 4; ++m) {
                const int row = row0 + ai * 128 + m * 16;
                const float rs = rsv[ai * 4 + m];
                u32x4 wq[2];
#pragma unroll
                for (int bj = 0; bj < 2; ++bj) {
                    float v[8];
#pragma unroll
                    for (int j = 0; j < 4; ++j) { v[j] = acc[ai][bj][m][0][j] * rs; v[4 + j] = acc[ai][bj][m][1][j] * rs; }
                    if (t == 0) {
#pragma unroll
                        for (int j = 0; j < 8; ++j) v[j] = gelu_tanh_f(v[j]);
                    } else {
#pragma unroll
                        for (int j = 0; j < 8; ++j) v[j] = sigmoid_f(v[j]);
                    }
                    wq[bj].x = cvt_pk_bf16(v[0], v[1]); wq[bj].y = cvt_pk_bf16(v[2], v[3]); wq[bj].z = cvt_pk_bf16(v[4], v[5]); wq[bj].w = cvt_pk_bf16(v[6], v[7]);
                }
                const bool odd = fr & 1; u32x4 va, vb; pair_lines(odd, wq[0], wq[1], va, vb);
                bf16_t* pa = base + (size_t)(row & ~1) * DM + col0 + (odd ? 32 : 0);
                st_nt(pa, va); st_nt(pa + DM, vb);
            }
    }
};

struct EpiInT {
    static constexpr bool PERM = false, SWAP = true;
    __device__ __forceinline__ void operator()(const AccT& acc, const pg8::Unit& u, int wr, int wc, int fr, int fq) const {
        unsigned char* ws = get_params()->ws; bf16_t* AinT = (bf16_t*)(ws + WS_AINT); bf16_t* VT = (bf16_t*)(ws + WS_VT); const float* rowss = (const float*)(ws + WS_RSA);
        const int b = u.pm >> 3, n0 = (u.pm & 7) * 256;
        const bool isv = u.pn >= 2;
        bf16_t* base = isv ? VT + ((size_t)b * 1024 + (size_t)(u.pn - 2) * 256) * SEQ : AinT + ((size_t)b * 512 + (size_t)u.pn * 256) * SEQ;
        float rsv[32];
#pragma unroll
        for (int g = 0; g < 8; ++g)
#pragma unroll
            for (int j = 0; j < 4; ++j) rsv[g * 4 + j] = rowss[(size_t)(u.pm * 256 + (g >> 2) * 128 + wr * 64 + (g & 3) * 16 + 4 * fq + j) * 16 + fr];
#pragma unroll
        for (int i = 0; i < 32; ++i) rsv[i] = __builtin_amdgcn_rsqf(dpp_row_sum16(rsv[i]) * (1.0f / 1024.0f) + EPS);
        asm volatile("s_waitcnt vmcnt(0)" ::: "memory");
#pragma unroll
        for (int ai = 0; ai < 2; ++ai)
#pragma unroll
            for (int m = 0; m < 4; ++m) {
                const int rl = ai * 128 + wr * 64 + m * 16 + 4 * fq;
#pragma unroll
                for (int bj = 0; bj < 2; ++bj) {
                    u32x2 wn[2];
#pragma unroll
                    for (int n = 0; n < 2; ++n) {
                        float v[4];
#pragma unroll
                        for (int j = 0; j < 4; ++j) v[j] = acc[ai][bj][m][n][j] * rsv[(ai * 4 + m) * 4 + j];
                        if (isv) {
#pragma unroll
                            for (int j = 0; j < 4; ++j) v[j] = gelu_tanh_f(v[j]);
                        }
                        wn[n].x = cvt_pk_bf16(v[0], v[1]); wn[n].y = cvt_pk_bf16(v[2], v[3]);
                    }
                    const u32x2 sx = __builtin_amdgcn_permlane16_swap(wn[0].x, wn[1].x, false, false);
                    const u32x2 sy = __builtin_amdgcn_permlane16_swap(wn[0].y, wn[1].y, false, false);
                    u32x4 w; w.x = sx.x; w.y = sy.x; w.z = sx.y; w.w = sy.y;
                    const int cl = bj * 128 + wc * 32 + (fq & 1) * 16 + fr;
                    *(u32x4*)(base + (size_t)cl * SEQ + n0 + rl - (fq & 1) * 4) = w;
                }
            }
    }
};

struct EpiDft {
    static constexpr bool PERM = true, SWAP = false;
    __device__ __forceinline__ void operator()(const AccT& acc, const pg8::Unit& u, int wr, int wc, int fr, int fq) const {
        bf16_t* YA = (bf16_t*)(get_params()->ws + WS_YA);
        const int b = u.pn >> 1;
        const int c0 = (u.pn & 1) * 256 + wc * 64 + 8 * fq;
        bf16_t* yb = YA + (size_t)b * SEQ * DM;
        asm volatile("s_waitcnt vmcnt(0)" ::: "memory");
#pragma unroll
        for (int ai = 0; ai < 2; ++ai)
#pragma unroll
            for (int m = 0; m < 4; ++m) {
                const int r = u.pm * 256 + ai * 128 + wr * 64 + m * 16 + fr;
#pragma unroll
                for (int bj = 0; bj < 2; ++bj) {
                    const f32x4 a0 = acc[ai][bj][m][0], a1 = acc[ai][bj][m][1];
                    u32x4 w; w.x = cvt_pk_bf16(a0[0], a0[1]); w.y = cvt_pk_bf16(a0[2], a0[3]); w.z = cvt_pk_bf16(a1[0], a1[1]); w.w = cvt_pk_bf16(a1[2], a1[3]);
                    const int c = c0 + bj * 32;
                    if (r <= 1024) {
                        *(u32x4*)(yb + (size_t)r * DM + c) = w;
                        if (r != 0 && r != 1024) *(u32x4*)(yb + (size_t)(SEQ - r) * DM + c) = w;
                        else *(u32x4*)(yb + (size_t)r * DM + 512 + c) = (u32x4){0u, 0u, 0u, 0u};
                    } else {
                        const int kk = r - 1024;
                        *(u32x4*)(yb + (size_t)kk * DM + 512 + c) = w;
                        u32x4 wn; wn.x = w.x ^ 0x80008000u; wn.y = w.y ^ 0x80008000u; wn.z = w.z ^ 0x80008000u; wn.w = w.w ^ 0x80008000u;
                        *(u32x4*)(yb + (size_t)(SEQ - kk) * DM + 512 + c) = wn;
                    }
                }
            }
    }
};

struct EpiGateM {
    static constexpr bool PERM = true, SWAP = false;
    __device__ __forceinline__ void mid(AccT& acc, const pg8::Unit& u, int wr, int wc, int fr, int fq) const {
        unsigned char* ws = get_params()->ws; const bf16_t* GA = (const bf16_t*)(ws + WS_GA); const bf16_t* GB = (const bf16_t*)(ws + WS_GB);
        const size_t off0 = (size_t)(u.pm * 256 + wr * 64 + fr) * DM + u.pn * 256 + wc * 64 + 8 * fq;
        u32x4 ga[2][2][2], gb[2][2][2];
#define GM_LOAD(k_, buf_) do { _Pragma("unroll") for (int mm = 0; mm < 2; ++mm) _Pragma("unroll") for (int bj = 0; bj < 2; ++bj) { \
            const size_t off = off0 + (size_t)(((k_) >> 1) * 128 + (((k_) & 1) * 2 + mm) * 16) * DM + bj * 32; \
            ga[buf_][mm][bj] = *(const u32x4*)(GA + off); gb[buf_][mm][bj] = *(const u32x4*)(GB + off); } } while (0)
        GM_LOAD(0, 0);
#pragma unroll
        for (int k = 0; k < 4; ++k) {
            if (k < 3) GM_LOAD(k + 1, (k + 1) & 1);
            asm volatile("" ::: "memory");
            const int ai = k >> 1;
#pragma unroll
            for (int mm = 0; mm < 2; ++mm)
#pragma unroll
                for (int bj = 0; bj < 2; ++bj) {
                    const int m = (k & 1) * 2 + mm;
                    const u32x4 a4 = ga[k & 1][mm][bj], b4 = gb[k & 1][mm][bj];
                    float r[8];
                    r[0] = bf_lo(a4.x) * __builtin_amdgcn_rcpf(fmaxf(bf_lo(b4.x), 1e-20f)); r[1] = bf_hi(a4.x) * __builtin_amdgcn_rcpf(fmaxf(bf_hi(b4.x), 1e-20f));
                    r[2] = bf_lo(a4.y) * __builtin_amdgcn_rcpf(fmaxf(bf_lo(b4.y), 1e-20f)); r[3] = bf_hi(a4.y) * __builtin_amdgcn_rcpf(fmaxf(bf_hi(b4.y), 1e-20f));
                    r[4] = bf_lo(a4.z) * __builtin_amdgcn_rcpf(fmaxf(bf_lo(b4.z), 1e-20f)); r[5] = bf_hi(a4.z) * __builtin_amdgcn_rcpf(fmaxf(bf_hi(b4.z), 1e-20f));
                    r[6] = bf_lo(a4.w) * __builtin_amdgcn_rcpf(fmaxf(bf_lo(b4.w), 1e-20f)); r[7] = bf_hi(a4.w) * __builtin_amdgcn_rcpf(fmaxf(bf_hi(b4.w), 1e-20f));
#pragma unroll
                    for (int j = 0; j < 4; ++j) { acc[ai][bj][m][0][j] *= r[j]; acc[ai][bj][m][1][j] *= r[4 + j]; }
                }
        }
#undef GM_LOAD
    }
    __device__ __forceinline__ void operator()(const AccT& acc, const pg8::Unit& u, int wr, int wc, int fr, int fq) const {
        unsigned char* ws = get_params()->ws; const bf16_t* GB = (const bf16_t*)(ws + WS_GB); bf16_t* MRG = (bf16_t*)(ws + WS_MRG);
        const size_t off0 = (size_t)(u.pm * 256 + wr * 64 + fr) * DM + u.pn * 256 + wc * 64 + 8 * fq;
        u32x4 gb[8][2];
#pragma unroll
        for (int g = 0; g < 8; ++g)
#pragma unroll
            for (int bj = 0; bj < 2; ++bj) gb[g][bj] = *(const u32x4*)(GB + off0 + (size_t)((g >> 2) * 128 + (g & 3) * 16) * DM + bj * 32);
        asm volatile("s_waitcnt vmcnt(0)" ::: "memory");
        const bool odd = fr & 1;
#pragma unroll
        for (int g = 0; g < 8; ++g) {
            const int ai = g >> 2, m = g & 3;
            u32x4 wq[2];
#pragma unroll
            for (int bj = 0; bj < 2; ++bj) {
                const u32x4 b4 = gb[g][bj];
                const f32x4 a0 = acc[ai][bj][m][0], a1 = acc[ai][bj][m][1];
                wq[bj].x = cvt_pk_bf16(a0[0] * fmaxf(bf_lo(b4.x), 1e-20f), a0[1] * fmaxf(bf_hi(b4.x), 1e-20f)); wq[bj].y = cvt_pk_bf16(a0[2] * fmaxf(bf_lo(b4.y), 1e-20f), a0[3] * fmaxf(bf_hi(b4.y), 1e-20f));
                wq[bj].z = cvt_pk_bf16(a1[0] * fmaxf(bf_lo(b4.z), 1e-20f), a1[1] * fmaxf(bf_hi(b4.z), 1e-20f)); wq[bj].w = cvt_pk_bf16(a1[2] * fmaxf(bf_lo(b4.w), 1e-20f), a1[3] * fmaxf(bf_hi(b4.w), 1e-20f));
            }
            u32x4 va, vb; pair_lines(odd, wq[0], wq[1], va, vb);
            bf16_t* pa = MRG + ((long)off0 + (long)(ai * 128 + m * 16 - (odd ? 1 : 0)) * DM + (odd ? 32 : 0));
            *(u32x4*)pa = va; *(u32x4*)(pa + DM) = vb;
        }
    }
};

struct EpiRes {
    static constexpr bool PERM = true, SWAP = false;
    bool to_b;
    __device__ __forceinline__ void operator()(const AccT& acc, const pg8::Unit& u, int wr, int wc, int fr, int fq) const {
        unsigned char* ws = get_params()->ws; bf16_t* XB = (bf16_t*)(ws + WS_XB); float* rowss = (float*)(ws + (to_b ? WS_RSB : WS_RSA));
        const int col0 = u.pn * 256 + wc * 64 + 8 * fq;
        const int row0 = u.pm * 256 + wr * 64 + fr;
        u32x4 xv[8][2];
#pragma unroll
        for (int g = 0; g < 8; ++g)
#pragma unroll
            for (int bj = 0; bj < 2; ++bj) xv[g][bj] = *(const u32x4*)(XB + (size_t)(row0 + (g >> 2) * 128 + (g & 3) * 16) * DM + col0 + bj * 32);
        asm volatile("s_waitcnt vmcnt(0)" ::: "memory");
        float ssv[8];
#pragma unroll
        for (int g = 0; g < 8; ++g) {
            const int ai = g >> 2, m = g & 3;
            const int row = row0 + ai * 128 + m * 16;
            float ss = 0.f;
#pragma unroll
            for (int bj = 0; bj < 2; ++bj) {
                const u32x4 x4 = xv[g][bj];
                const f32x4 a0 = acc[ai][bj][m][0], a1 = acc[ai][bj][m][1];
                u32x4 w;
                w.x = cvt_pk_bf16(bf_lo(x4.x) + a0[0], bf_hi(x4.x) + a0[1]); w.y = cvt_pk_bf16(bf_lo(x4.y) + a0[2], bf_hi(x4.y) + a0[3]);
                w.z = cvt_pk_bf16(bf_lo(x4.z) + a1[0], bf_hi(x4.z) + a1[1]); w.w = cvt_pk_bf16(bf_lo(x4.w) + a1[2], bf_hi(x4.w) + a1[3]);
                *(u32x4*)(XB + (size_t)row * DM + col0 + bj * 32) = w;
                const float y0 = bf_lo(w.x), y1 = bf_hi(w.x), y2 = bf_lo(w.y), y3 = bf_hi(w.y), y4 = bf_lo(w.z), y5 = bf_hi(w.z), y6 = bf_lo(w.w), y7 = bf_hi(w.w);
                ss += (y0 * y0 + y1 * y1) + (y2 * y2 + y3 * y3) + (y4 * y4 + y5 * y5) + (y6 * y6 + y7 * y7);
            }
            ss += __shfl_xor(ss, 16); ss += __shfl_xor(ss, 32);
            ssv[g] = ss;
        }
        const float sa = fq == 0 ? ssv[0] : (fq == 1 ? ssv[2] : (fq == 2 ? ssv[4] : ssv[6]));
        const float sb = fq == 0 ? ssv[1] : (fq == 1 ? ssv[3] : (fq == 2 ? ssv[5] : ssv[7]));
        const int ga = 2 * fq, gb = 2 * fq + 1;
        rowss[(size_t)(row0 + (ga >> 2) * 128 + (ga & 3) * 16) * 16 + u.pn * 4 + wc] = sa;
        rowss[(size_t)(row0 + (gb >> 2) * 128 + (gb & 3) * 16) * 16 + u.pn * 4 + wc] = sb;
    }
};

struct EpiUp {
    static constexpr bool PERM = true, SWAP = false;
    __device__ __forceinline__ void operator()(const AccT& acc, const pg8::Unit& u, int wr, int wc, int fr, int fq) const {
        unsigned char* ws = get_params()->ws; bf16_t* F = (bf16_t*)(ws + WS_F); const float* rowss = (const float*)(ws + WS_RSB);
        const int col0 = u.pn * 256 + wc * 64 + 8 * fq;
        const int row0 = u.pm * 256 + wr * 64 + fr;
        float rsv[8]; rows_rs8(rowss, row0, fq, rsv);
#pragma unroll
        for (int ai = 0; ai < 2; ++ai)
#pragma unroll
            for (int m = 0; m < 4; ++m) {
                const int row = row0 + ai * 128 + m * 16;
                const float rs = rsv[ai * 4 + m];
                u32x4 wq[2];
#pragma unroll
                for (int bj = 0; bj < 2; ++bj) {
                    float v[8];
#pragma unroll
                    for (int j = 0; j < 4; ++j) { v[j] = acc[ai][bj][m][0][j] * rs; v[4 + j] = acc[ai][bj][m][1][j] * rs; }
#pragma unroll
                    for (int j = 0; j < 8; ++j) { const float r = fmaxf(v[j], 0.f); v[j] = r * r; }
                    wq[bj].x = cvt_pk_bf16(v[0], v[1]); wq[bj].y = cvt_pk_bf16(v[2], v[3]); wq[bj].z = cvt_pk_bf16(v[4], v[5]); wq[bj].w = cvt_pk_bf16(v[6], v[7]);
                }
                const bool odd = fr & 1; u32x4 va, vb; pair_lines(odd, wq[0], wq[1], va, vb);
                bf16_t* pa = F + (size_t)(row & ~1) * DFF + col0 + (odd ? 32 : 0);
                st_nt(pa, va); st_nt(pa + DFF, vb);
            }
    }
};

#define XB_TMO      128
#define XB_XCNT(j)  (256  + 64 * (j))
#define XB_XSUB(j)  (1280 + 64 * (j))
#define XB_XGEN(j)  (2304 + 64 * (j))
#define XB_TOP      3328
#define XB_TOPGEN   3392
#define XB_SPIN_CAP (1u << 22)
constexpr int LDS_BAR_OFF = 131072;
__device__ __forceinline__ unsigned xb_ld(unsigned* p)              { return __hip_atomic_load(p, __ATOMIC_RELAXED, __HIP_MEMORY_SCOPE_AGENT); }
__device__ __forceinline__ unsigned xb_add(unsigned* p, unsigned v) { return __hip_atomic_fetch_add(p, v, __ATOMIC_RELAXED, __HIP_MEMORY_SCOPE_AGENT); }
__device__ __forceinline__ unsigned xb_xcc_id() { return (unsigned)__builtin_amdgcn_s_getreg((3 << 11) | 20) & 0xFu; }
#define XB_SPIN(cond, bar) do { unsigned _sp = 0; while (cond) { __builtin_amdgcn_s_sleep(1); \
    if ((++_sp & 255u) == 0u) { if (xb_ld(&(bar)[XB_TMO])) break; if (_sp > XB_SPIN_CAP) { atomicAdd(&(bar)[XB_TMO], 1u); break; } } } } while (0)
__device__ __forceinline__ void xcd_barrier_complete(unsigned* bar, unsigned x, unsigned& nloc, unsigned& nx) {
    const unsigned G = gridDim.x;
    unsigned sum, cnt, mine, sp = 0u;
    for (;;) {
        sum = 0u; cnt = 0u; mine = 0u;
#pragma unroll
        for (unsigned j = 0; j < 16; ++j) { const unsigned c = xb_ld(&bar[XB_XCNT(j)]); sum += c; cnt += (c > 0u) ? 1u : 0u; mine = (j == x) ? c : mine; }
        if (sum == G) break;
        __builtin_amdgcn_s_sleep(1);
        if ((++sp & 255u) == 0u) { if (xb_ld(&bar[XB_TMO])) break; if (sp > XB_SPIN_CAP) { atomicAdd(&bar[XB_TMO], 1u); break; } }
    }
    nloc = mine > 0u ? mine : 1u; nx = cnt > 0u ? cnt : 1u;
}
__device__ __forceinline__ void grid_barrier_post(LAS unsigned char* lds) {
    unsigned* bar = (unsigned*)(get_params()->ws + WS_BAR);
    if (threadIdx.x == 0) {
        volatile LAS unsigned* st = (volatile LAS unsigned*)(lds + LDS_BAR_OFF); st[0] = 0u; st[1] = 0u;
        (void)xb_add(&bar[XB_XCNT(xb_xcc_id())], 1u);
    }
    __syncthreads();
}
__device__ __forceinline__ void grid_barrier(LAS unsigned char* lds) {
    asm volatile("s_waitcnt vmcnt(0)" ::: "memory");
    unsigned* bar = (unsigned*)(get_params()->ws + WS_BAR);
    __syncthreads();
    if (threadIdx.x == 0) {
        volatile LAS unsigned* st = (volatile LAS unsigned*)(lds + LDS_BAR_OFF);
        const unsigned x = xb_xcc_id();
        __builtin_amdgcn_s_waitcnt(0);
        unsigned nloc = st[0], nx = st[1];
        if (nloc == 0u) { xcd_barrier_complete(bar, x, nloc, nx); st[0] = nloc; st[1] = nx; }
        const unsigned old = xb_add(&bar[XB_XSUB(x)], 1u);
        const unsigned gen = old / nloc;
        if (old + 1u == (gen + 1u) * nloc) {
            __builtin_amdgcn_fence(__ATOMIC_RELEASE, "agent");
            asm volatile("s_waitcnt vmcnt(0)" ::: "memory");
            const unsigned og = xb_add(&bar[XB_TOP], 1u);
            const unsigned tg = og / nx;
            if (og + 1u == (tg + 1u) * nx) xb_add(&bar[XB_TOPGEN], 1u);
            else XB_SPIN(xb_ld(&bar[XB_TOPGEN]) == tg, bar);
            __builtin_amdgcn_fence(__ATOMIC_ACQUIRE, "agent");
            xb_add(&bar[XB_XGEN(x)], 1u);
            asm volatile("s_waitcnt vmcnt(0)" ::: "memory");
        } else {
            XB_SPIN(xb_ld(&bar[XB_XGEN(x)]) == gen, bar);
            __builtin_amdgcn_fence(__ATOMIC_ACQUIRE, "agent");
            asm volatile("s_waitcnt vmcnt(0)" ::: "memory");
        }
    }
    __syncthreads();
}

struct ConvItem { const float* src; bf16_t* dst; const float* scale; int ldn, ldk, k0, n0, rowmode; };
__device__ __forceinline__ ConvItem conv_decode(KParams KP, unsigned char* ws, int it) {
    constexpr int T_IN = 16 * 72, T_SQ = 16 * 16, T_UP = 16 * 64, T_DN = 64 * 16, T_L = T_IN + 2 * T_SQ + T_UP + T_DN;
    const int l = it / T_L; int r = it % T_L; ConvItem c;
    if (r < T_IN) { c.src = KP->in[2] + (size_t)l * DM * INC; c.ldn = INC; c.dst = (bf16_t*)(ws + WS_WIN) + (size_t)l * INC * DM; c.ldk = DM; c.k0 = (r / 72) * 64; c.n0 = (r % 72) * 64; c.scale = KP->in[1] + l * DM; c.rowmode = 1; return c; } r -= T_IN;
    if (r < T_SQ) { c.src = KP->in[8] + (size_t)l * DM * DM; c.ldn = DM; c.dst = (bf16_t*)(ws + WS_WB) + (size_t)l * DM * DM; c.ldk = DM; c.k0 = (r / 16) * 64; c.n0 = (r % 16) * 64; c.scale = nullptr; c.rowmode = 0; return c; } r -= T_SQ;
    if (r < T_SQ) { c.src = KP->in[9] + (size_t)l * DM * DM; c.ldn = DM; c.dst = (bf16_t*)(ws + WS_WOUT) + (size_t)l * DM * DM; c.ldk = DM; c.k0 = (r / 16) * 64; c.n0 = (r % 16) * 64; c.scale = nullptr; c.rowmode = 0; return c; } r -= T_SQ;
    if (r < T_UP) { c.src = KP->in[11] + (size_t)l * DM * DFF; c.ldn = DFF; c.dst = (bf16_t*)(ws + WS_WUP) + (size_t)l * DFF * DM; c.ldk = DM; c.k0 = (r / 64) * 64; c.n0 = (r % 64) * 64; c.scale = KP->in[10] + l * DM; c.rowmode = 0; return c; } r -= T_UP;
    c.src = KP->in[12] + (size_t)l * DFF * DM; c.ldn = DM; c.dst = (bf16_t*)(ws + WS_WDN) + (size_t)l * DM * DFF; c.ldk = DFF; c.k0 = (r / 16) * 64; c.n0 = (r % 16) * 64; c.scale = nullptr; c.rowmode = 0; return c;
}
__device__ __forceinline__ void conv_load(int tid, const ConvItem& c, f32x4& a, f32x4& b, float& sc) {
    const int k = tid >> 3, piece = (tid & 7) * 8;
    const float* s = c.src + (size_t)(c.k0 + k) * c.ldn + c.n0 + piece;
    a = *(const f32x4*)s; b = *(const f32x4*)(s + 4);
    sc = c.scale ? c.scale[c.k0 + k] : 1.0f;
}
__device__ __forceinline__ void conv_to_lds(int tid, LAS float* tile, const f32x4& a, const f32x4& b, float sc) {
    const int k = tid >> 3, piece = (tid & 7) * 8;
    LAS float* t = tile + k * 65 + piece;
    t[0] = a[0] * sc; t[1] = a[1] * sc; t[2] = a[2] * sc; t[3] = a[3] * sc; t[4] = b[0] * sc; t[5] = b[1] * sc; t[6] = b[2] * sc; t[7] = b[3] * sc;
}
__device__ __forceinline__ void conv_store(int tid, LAS float* tile, const ConvItem& c) {
    const int nl = tid >> 3, kp = (tid & 7) * 8;
    float v[8];
#pragma unroll
    for (int j = 0; j < 8; ++j) v[j] = tile[(kp + j) * 65 + nl];
    int n = c.n0 + nl;
    if (c.rowmode == 1) { if (n >= 512 && n < 1536) n += 1024; else if (n >= 1536 && n < 2560) n -= 1024; }
    u32x4 w; w.x = cvt_pk_bf16(v[0], v[1]); w.y = cvt_pk_bf16(v[2], v[3]); w.z = cvt_pk_bf16(v[4], v[5]); w.w = cvt_pk_bf16(v[6], v[7]);
    *(u32x4*)(c.dst + (size_t)n * c.ldk + c.k0 + kp) = w;
}

__device__ __forceinline__ void wacs_tile(int tid, LAS float* tile, const float* wa_l, bf16_t* dst_l, int g, int dblk) {
    LAS float* trig = tile + 64 * 65;
    {
        const int m = tid >> 3, piece = (tid & 7) * 8;
        const float* s = wa_l + (size_t)(g * 64 + m) * DM + dblk * 64 + piece;
        const f32x4 a = *(const f32x4*)s, b = *(const f32x4*)(s + 4);
        LAS float* t = tile + m * 65 + piece;
        t[0] = a[0]; t[1] = a[1]; t[2] = a[2]; t[3] = a[3]; t[4] = b[0]; t[5] = b[1]; t[6] = b[2]; t[7] = b[3];
        if (tid < 64) { trig[tid] = cospif((float)tid * (1.0f / 32.0f)); trig[64 + tid] = sinpif((float)tid * (1.0f / 32.0f)); }
    }
    __syncthreads();
    {
        const int dl = tid >> 3, cp = (tid & 7) * 8;
        const float scale = 0.0027621358640099515f;
        float oc[8], os[8];
#pragma unroll
        for (int j = 0; j < 8; ++j) { oc[j] = 0.f; os[j] = 0.f; }
        for (int m = 0; m < 64; ++m) {
            const float w = tile[m * 65 + dl];
#pragma unroll
            for (int j = 0; j < 8; ++j) { const int idx = ((cp + j) * m) & 63; oc[j] += trig[idx] * w; os[j] += trig[64 + idx] * w; }
        }
        bf16_t* row = dst_l + (size_t)(dblk * 64 + dl) * DM + g * 64 + cp;
        u32x4 w; w.x = cvt_pk_bf16(oc[0] * scale, oc[1] * scale); w.y = cvt_pk_bf16(oc[2] * scale, oc[3] * scale); w.z = cvt_pk_bf16(oc[4] * scale, oc[5] * scale); w.w = cvt_pk_bf16(oc[6] * scale, oc[7] * scale);
        *(u32x4*)row = w;
        u32x4 z; z.x = cvt_pk_bf16(-os[0] * scale, -os[1] * scale); z.y = cvt_pk_bf16(-os[2] * scale, -os[3] * scale); z.z = cvt_pk_bf16(-os[4] * scale, -os[5] * scale); z.w = cvt_pk_bf16(-os[6] * scale, -os[7] * scale);
        *(u32x4*)(row + 512) = z;
    }
    __syncthreads();
}

__device__ __forceinline__ void prologue(LAS unsigned char* lds) {
    LAS float* tile = (LAS float*)lds;
    KParams KP = get_params();
    unsigned char* ws = KP->ws;
    int tid_ = threadIdx.x; asm volatile("" : "+v"(tid_));
    const int G = gridDim.x, bid = blockIdx.x, tid = tid_;
    {
        constexpr int T_ALL = DEPTH * (16 * 72 + 2 * 16 * 16 + 16 * 64 + 64 * 16);
        int it = bid; f32x4 ra, rb; float rsc = 1.f;
        if (it < T_ALL) { const ConvItem c = conv_decode(KP, ws, it); conv_load(tid, c, ra, rb, rsc); }
        while (it < T_ALL) {
            conv_to_lds(tid, tile, ra, rb, rsc);
            __syncthreads();
            const int nx = it + G;
            if (nx < T_ALL) { const ConvItem cn = conv_decode(KP, ws, nx); conv_load(tid, cn, ra, rb, rsc); }
            { const ConvItem c = conv_decode(KP, ws, it); conv_store(tid, tile, c); }
            __syncthreads();
            it = nx;
        }
    }
    for (int it = bid; it < DEPTH * 8 * 16; it += G) {
        const int l = it >> 7, g = (it >> 4) & 7, dblk = it & 15;
        wacs_tile(tid, tile, KP->in[3] + (size_t)l * 512 * DM, (bf16_t*)(ws + WS_WACS) + (size_t)l * DM * DM, g, dblk);
    }
    const size_t gt = (size_t)bid * 512 + tid, GT = (size_t)G * 512;
    {
        const float* src = KP->in[6]; bf16_t* dst = (bf16_t*)(ws + WS_WS);
        for (size_t i = gt; i < (size_t)DEPTH * 8 * 128 * 128 / 8; i += GT) {
            const f32x4 a = *(const f32x4*)(src + i * 8), b = *(const f32x4*)(src + i * 8 + 4);
            u32x4 w; w.x = cvt_pk_bf16(a[0], a[1]); w.y = cvt_pk_bf16(a[2], a[3]); w.z = cvt_pk_bf16(b[0], b[1]); w.w = cvt_pk_bf16(b[2], b[3]);
            *(u32x4*)(dst + i * 8) = w;
        }
        bf16_t* cs = (bf16_t*)(ws + WS_CS);
        for (size_t i = gt; i < (size_t)SEQ * SEQ / 8; i += GT) {
            const int r = (int)(i >> 8), n0 = (int)(i & 255) * 8;
            float v[8];
#pragma unroll
            for (int j = 0; j < 8; ++j) {
                const int n = n0 + j;
                if (r <= 1024) v[j] = cospif((float)((r * n) & 2047) * (1.0f / 1024.0f));
                else v[j] = sinpif((float)(((r - 1024) * n) & 2047) * (1.0f / 1024.0f));
            }
            u32x4 w; w.x = cvt_pk_bf16(v[0], v[1]); w.y = cvt_pk_bf16(v[2], v[3]); w.z = cvt_pk_bf16(v[4], v[5]); w.w = cvt_pk_bf16(v[6], v[7]);
            *(u32x4*)(cs + i * 8) = w;
        }
    }
    {
        const int lane = tid & 63, gw = bid * 8 + (tid >> 6), NGW = G * 8;
        const float* x = KP->in[0]; bf16_t* xb = (bf16_t*)(ws + WS_XB); float* rsa = (float*)(ws + WS_RSA);
        for (int row0 = gw * 2; row0 < T_TOK; row0 += NGW * 2) {
            f32x4 v[2][4];
#pragma unroll
            for (int r = 0; r < 2; ++r) { const float* xr = x + (size_t)(row0 + r) * DM + lane * 16;
                v[r][0] = *(const f32x4*)xr; v[r][1] = *(const f32x4*)(xr + 4); v[r][2] = *(const f32x4*)(xr + 8); v[r][3] = *(const f32x4*)(xr + 12); }
#pragma unroll
            for (int r = 0; r < 2; ++r) {
                const f32x4 a = v[r][0], b = v[r][1], c = v[r][2], d = v[r][3];
                float ss = (a[0] * a[0] + a[1] * a[1]) + (a[2] * a[2] + a[3] * a[3]) + (b[0] * b[0] + b[1] * b[1]) + (b[2] * b[2] + b[3] * b[3])
                         + (c[0] * c[0] + c[1] * c[1]) + (c[2] * c[2] + c[3] * c[3]) + (d[0] * d[0] + d[1] * d[1]) + (d[2] * d[2] + d[3] * d[3]);
#pragma unroll
                for (int o = 32; o >= 1; o >>= 1) ss += __shfl_xor(ss, o);
                u32x4 w0, w1; w0.x = cvt_pk_bf16(a[0], a[1]); w0.y = cvt_pk_bf16(a[2], a[3]); w0.z = cvt_pk_bf16(b[0], b[1]); w0.w = cvt_pk_bf16(b[2], b[3]);
                w1.x = cvt_pk_bf16(c[0], c[1]); w1.y = cvt_pk_bf16(c[2], c[3]); w1.z = cvt_pk_bf16(d[0], d[1]); w1.w = cvt_pk_bf16(d[2], d[3]);
                bf16_t* o = xb + (size_t)(row0 + r) * DM + lane * 16;
                *(u32x4*)o = w0; *(u32x4*)(o + 8) = w1;
                if (lane < 16) rsa[(size_t)(row0 + r) * 16 + lane] = lane == 0 ? ss : 0.f;
            }
        }
    }
}

__device__ __forceinline__ void sgu_phase(LAS unsigned char* lds, int layer) {
    KParams KP = get_params();
    int tid_ = threadIdx.x; asm volatile("" : "+v"(tid_));
    const int tid = tid_, lane = tid & 63, wave = tid >> 6, fr = lane & 15, fq = lane >> 4;
    LAS float* red = (LAS float*)lds;
    LAS float* stat = (LAS float*)(lds + 8192);
    LAS float* gbl = (LAS float*)(lds + 16384);
    unsigned char* ws = KP->ws;
    const bf16_t* VT = (const bf16_t*)(ws + WS_VT);
    bf16_t* U = (bf16_t*)(ws + WS_U);
    const bf16_t* WSB = (const bf16_t*)(ws + WS_WS) + (size_t)layer * 8 * 128 * 128;
    { const float* lng = KP->in[4] + layer * DM; const float* lnb = KP->in[5] + layer * DM; const float* bs = KP->in[7] + layer * 8 * 128;
      for (int i = tid; i < 1024; i += 512) { gbl[i] = lng[i]; gbl[1024 + i] = lnb[i]; gbl[2048 + i] = bs[i]; } }
    __syncthreads();
    for (int unit = blockIdx.x; unit < NBATCH * 16; unit += gridDim.x) {
        const int b = unit >> 4, chunk = unit & 15;
        const bf16_t* vt = VT + (size_t)b * 1024 * SEQ + chunk * 128;
        {
            const int pg = tid & 15, c0 = tid >> 4;
            float s[8], q[8];
#pragma unroll
            for (int j = 0; j < 8; ++j) { s[j] = 0.f; q[j] = 0.f; }
#pragma unroll 1
            for (int half = 0; half < 2; ++half) {
                u32x4 wv[16];
#pragma unroll
                for (int i = 0; i < 16; ++i) wv[i] = *(const u32x4*)(vt + (size_t)(c0 + 32 * (half * 16 + i)) * SEQ + pg * 8);
                asm volatile("s_waitcnt vmcnt(0)" ::: "memory");
#pragma unroll
                for (int i = 0; i < 16; ++i) {
                    const u32x4 w = wv[i];
                    const float v0 = bf_lo(w.x), v1 = bf_hi(w.x), v2 = bf_lo(w.y), v3 = bf_hi(w.y), v4 = bf_lo(w.z), v5 = bf_hi(w.z), v6 = bf_lo(w.w), v7 = bf_hi(w.w);
                    s[0] += v0; s[1] += v1; s[2] += v2; s[3] += v3; s[4] += v4; s[5] += v5; s[6] += v6; s[7] += v7;
                    q[0] += v0 * v0; q[1] += v1 * v1; q[2] += v2 * v2; q[3] += v3 * v3; q[4] += v4 * v4; q[5] += v5 * v5; q[6] += v6 * v6; q[7] += v7 * v7;
                }
            }
#pragma unroll
            for (int j = 0; j < 8; ++j) { s[j] += __shfl_xor(s[j], 16); s[j] += __shfl_xor(s[j], 32); q[j] += __shfl_xor(q[j], 16); q[j] += __shfl_xor(q[j], 32); }
            if (lane < 16) {
#pragma unroll
                for (int j = 0; j < 8; ++j) { red[(wave * 128 + pg * 8 + j) * 2] = s[j]; red[(wave * 128 + pg * 8 + j) * 2 + 1] = q[j]; }
            }
        }
        __syncthreads();
        if (tid < 128) {
            float s = 0.f, q = 0.f;
#pragma unroll
            for (int w = 0; w < 8; ++w) { s += red[(w * 128 + tid) * 2]; q += red[(w * 128 + tid) * 2 + 1]; }
            const float mean = s * (1.0f / 1024.0f); const float var = fmaxf(q * (1.0f / 1024.0f) - mean * mean, 0.f);
            stat[tid * 2] = mean; stat[tid * 2 + 1] = __builtin_amdgcn_rsqf(var + EPS);
        }
        __syncthreads();
        const int qrow = 16 * wave + fr;
        const size_t tok = (size_t)b * SEQ + chunk * 128 + qrow;
        LAS unsigned char* vbuf = lds + 32768;
        u32x4 wA[4]; u32x4 tl[4]; u32x4 uw[4];
#define SGU_G(d_) ((((d_) & 3) << 2) | ((-((d_) >> 5)) & 3))
#define SGU_LOAD(h_) do { const bf16_t* wsrow_ = WSB + ((size_t)(h_) * 128 + qrow) * 128 + 8 * fq; const bf16_t* up_ = U + tok * DM + (h_) * 128 + 32 * fq; \
            _Pragma("unroll") for (int ks = 0; ks < 4; ++ks) wA[ks] = *(const u32x4*)(wsrow_ + 32 * ks); \
            _Pragma("unroll") for (int i = 0; i < 4; ++i) { const int id_ = tid + 512 * i; tl[i] = *(const u32x4*)(vt + (size_t)((h_) * 128 + (id_ >> 4)) * SEQ + (id_ & 15) * 8); } \
            _Pragma("unroll") for (int n2 = 0; n2 < 4; ++n2) uw[n2] = *(const u32x4*)(up_ + 8 * n2); } while (0)
        SGU_LOAD(0);
#pragma unroll 1
        for (int h = 0; h < 8; ++h) {
            LAS unsigned char* vb = vbuf + (h & 1) * 32768;
#pragma unroll
            for (int i = 0; i < 4; ++i) { const int id_ = tid + 512 * i, d_ = id_ >> 4, c_ = id_ & 15; *(LAS u32x4*)(vb + d_ * 256 + ((c_ ^ SGU_G(d_)) << 4)) = tl[i]; }
            u32x4 wcur[4], ucur[4];
#pragma unroll
            for (int i = 0; i < 4; ++i) { wcur[i] = wA[i]; ucur[i] = uw[i]; }
            __syncthreads();
            if (h < 7) SGU_LOAD(h + 1);
            bf16x8 Af[4]; float c1 = 0.f, c2 = 0.f;
            f32x4 sv[16];
#pragma unroll
            for (int i = 0; i < 16; ++i) sv[i] = *(const LAS f32x4*)(stat + (32 * (i >> 2) + 8 * fq + 2 * (i & 3)) * 2);
            asm volatile("s_waitcnt lgkmcnt(0)" ::: "memory");
#pragma unroll
            for (int ks = 0; ks < 4; ++ks) {
                const u32x4 w = wcur[ks];
                float a[8] = {bf_lo(w.x), bf_hi(w.x), bf_lo(w.y), bf_hi(w.y), bf_lo(w.z), bf_hi(w.z), bf_lo(w.w), bf_hi(w.w)};
                unsigned pk[4];
#pragma unroll
                for (int j = 0; j < 8; j += 2) {
                    const f32x4 st4 = sv[ks * 4 + (j >> 1)];
                    const float m0 = st4[0], r0 = st4[1], m1 = st4[2], r1 = st4[3];
                    const unsigned pw = cvt_pk_bf16(a[j] * r0, a[j + 1] * r1);
                    c1 += bf_lo(pw) * m0 + bf_hi(pw) * m1; c2 += a[j] + a[j + 1];
                    pk[j >> 1] = pw;
                }
                u32x4 t; t.x = pk[0]; t.y = pk[1]; t.z = pk[2]; t.w = pk[3];
                Af[ks] = __builtin_bit_cast(bf16x8, t);
            }
            c1 += __shfl_xor(c1, 16); c1 += __shfl_xor(c1, 32); c2 += __shfl_xor(c2, 16); c2 += __shfl_xor(c2, 32);
            f32x4 acc[8];
#pragma unroll
            for (int n = 0; n < 8; ++n) acc[n] = (f32x4){0.f, 0.f, 0.f, 0.f};
            const int dbase = 32 * (fr >> 2) + (fr & 3);
            const int gsw = (((fr & 3) << 2) | ((-(fr >> 2)) & 3));
#pragma unroll
            for (int half = 0; half < 2; ++half) {
                bf16x8 bfr[2][8];
#pragma unroll
                for (int k2 = 0; k2 < 2; ++k2)
#pragma unroll
                    for (int n = 0; n < 8; ++n) bfr[k2][n] = *(const LAS bf16x8*)(vb + (dbase + 4 * n) * 256 + (((4 * (half * 2 + k2) + fq) ^ gsw) << 4));
                asm volatile("s_waitcnt lgkmcnt(0)" ::: "memory");
#pragma unroll
                for (int k2 = 0; k2 < 2; ++k2)
#pragma unroll
                    for (int n = 0; n < 8; ++n) acc[n] = __builtin_amdgcn_mfma_f32_16x16x32_bf16(bfr[k2][n], Af[half * 2 + k2], acc[n], 0, 0, 0);
            }
            const float bsv = gbl[2048 + h * 128 + qrow];
            const int ch0 = h * 128 + 32 * fq;
            bf16_t* up = U + tok * DM + ch0;
#pragma unroll
            for (int n2 = 0; n2 < 4; ++n2) {
                const u32x4 uwv = ucur[n2];
                const f32x4 g0 = *(const LAS f32x4*)(gbl + ch0 + 8 * n2), g1 = *(const LAS f32x4*)(gbl + ch0 + 8 * n2 + 4);
                const f32x4 b0 = *(const LAS f32x4*)(gbl + 1024 + ch0 + 8 * n2), b1 = *(const LAS f32x4*)(gbl + 1024 + ch0 + 8 * n2 + 4);
                const f32x4 a0 = acc[2 * n2], a1 = acc[2 * n2 + 1];
                float o[8];
                o[0] = bf_lo(uwv.x) * (g0[0] * (a0[0] - c1) + b0[0] * c2 + bsv); o[1] = bf_hi(uwv.x) * (g0[1] * (a0[1] - c1) + b0[1] * c2 + bsv);
                o[2] = bf_lo(uwv.y) * (g0[2] * (a0[2] - c1) + b0[2] * c2 + bsv); o[3] = bf_hi(uwv.y) * (g0[3] * (a0[3] - c1) + b0[3] * c2 + bsv);
                o[4] = bf_lo(uwv.z) * (g1[0] * (a1[0] - c1) + b1[0] * c2 + bsv); o[5] = bf_hi(uwv.z) * (g1[1] * (a1[1] - c1) + b1[1] * c2 + bsv);
                o[6] = bf_lo(uwv.w) * (g1[2] * (a1[2] - c1) + b1[2] * c2 + bsv); o[7] = bf_hi(uwv.w) * (g1[3] * (a1[3] - c1) + b1[3] * c2 + bsv);
                u32x4 w; w.x = cvt_pk_bf16(o[0], o[1]); w.y = cvt_pk_bf16(o[2], o[3]); w.z = cvt_pk_bf16(o[4], o[5]); w.w = cvt_pk_bf16(o[6], o[7]);
                *(u32x4*)(up + 8 * n2) = w;
            }
        }
#undef SGU_LOAD
#undef SGU_G
        __syncthreads();
    }
}

__device__ __forceinline__ void final_norm() {
    KParams KP = get_params();
    int tid_ = threadIdx.x; asm volatile("" : "+v"(tid_));
    const int tid = tid_, lane = tid & 63, gw = blockIdx.x * 8 + (tid >> 6), NGW = gridDim.x * 8;
    const float* rsa = (const float*)(KP->ws + WS_RSA); const float* gf = KP->in[13]; float* outp = KP->out; const bf16_t* xb = (const bf16_t*)(KP->ws + WS_XB);
    const f32x4 g0 = *(const f32x4*)(gf + lane * 16), g1 = *(const f32x4*)(gf + lane * 16 + 4), g2 = *(const f32x4*)(gf + lane * 16 + 8), g3 = *(const f32x4*)(gf + lane * 16 + 12);
    for (int row0 = gw * 4; row0 < T_TOK; row0 += NGW * 4) {
        float sv[4]; u32x4 w0[4], w1[4];
#pragma unroll
        for (int r = 0; r < 4; ++r) { const int row = row0 + r; sv[r] = rsa[(size_t)row * 16 + (lane & 15)];
            w0[r] = *(const u32x4*)(xb + (size_t)row * DM + lane * 16); w1[r] = *(const u32x4*)(xb + (size_t)row * DM + lane * 16 + 8); }
#pragma unroll
        for (int r = 0; r < 4; ++r) {
            float s = sv[r];
            s += __shfl_xor(s, 1); s += __shfl_xor(s, 2); s += __shfl_xor(s, 4); s += __shfl_xor(s, 8);
            const float rs = __builtin_amdgcn_rsqf(s * (1.0f / 1024.0f) + EPS);
            float* xr = outp + (size_t)(row0 + r) * DM + lane * 16;
            f32x4 a = {bf_lo(w0[r].x), bf_hi(w0[r].x), bf_lo(w0[r].y), bf_hi(w0[r].y)}, b = {bf_lo(w0[r].z), bf_hi(w0[r].z), bf_lo(w0[r].w), bf_hi(w0[r].w)};
            f32x4 c = {bf_lo(w1[r].x), bf_hi(w1[r].x), bf_lo(w1[r].y), bf_hi(w1[r].y)}, d = {bf_lo(w1[r].z), bf_hi(w1[r].z), bf_lo(w1[r].w), bf_hi(w1[r].w)};
            a = a * rs * g0; b = b * rs * g1; c = c * rs * g2; d = d * rs * g3;
            *(f32x4*)xr = a; *(f32x4*)(xr + 4) = b; *(f32x4*)(xr + 8) = c; *(f32x4*)(xr + 12) = d;
        }
    }
}

__global__ void __launch_bounds__(512, 2) fwd_kernel(Params P_unused) {
    extern __shared__ __attribute__((aligned(16))) unsigned char smem[];
    LAS unsigned char* lds = (LAS unsigned char*)smem;
    cg::grid_group grid = cg::this_grid();

    grid_barrier_post(lds);
    prologue(lds);
    grid.sync();

#pragma unroll 1
    for (int l = 0; l < DEPTH; ++l) {
        { KParams KP = get_params(); unsigned char* ws = KP->ws; const bf16_t* Win = (const bf16_t*)(ws + WS_WIN) + (size_t)l * INC * DM;
          pg8::Gemm g{(const bf16_t*)(ws + WS_XB), Win}; pg8::StaticOrder<T_TOK, 1536> S; S.init(gridDim.x, blockIdx.x);
          EpiInT E{}; pg8::gemm_phase<EpiInT, true, T_TOK, 1536, DM>(lds, g, S, E); }
        { KParams KP = get_params(); unsigned char* ws = KP->ws; const bf16_t* Win = (const bf16_t*)(ws + WS_WIN) + (size_t)l * INC * DM;
          pg8::Gemm g{(const bf16_t*)(ws + WS_XB), Win + (size_t)1536 * DM}; pg8::StaticOrder<T_TOK, 3072> S; S.init(gridDim.x, blockIdx.x);
          EpiIn E{}; pg8::gemm_phase<EpiIn, true, T_TOK, 3072, DM>(lds, g, S, E); }
        grid_barrier(lds);
        { KParams KP = get_params(); unsigned char* ws = KP->ws;
          pg8::Gemm g{(const bf16_t*)(ws + WS_CS), (const bf16_t*)(ws + WS_AINT)}; pg8::StaticOrder<SEQ, NBATCH * 512> S; S.init(gridDim.x, blockIdx.x);
          EpiDft E{}; pg8::gemm_phase<EpiDft, true, SEQ, NBATCH * 512, SEQ>(lds, g, S, E); }
        sgu_phase(lds, l);
        grid_barrier(lds);
        { KParams KP = get_params(); unsigned char* ws = KP->ws;
          pg8::Gemm g{(const bf16_t*)(ws + WS_YA), (const bf16_t*)(ws + WS_WACS) + (size_t)l * DM * DM, (const bf16_t*)(ws + WS_U), (const bf16_t*)(ws + WS_WB) + (size_t)l * DM * DM};
          pg8::StaticOrder<T_TOK, DM> S; S.init(gridDim.x, blockIdx.x);
          EpiGateM E{}; pg8::gemm_phase<EpiGateM, true, T_TOK, DM, 2 * DM, DM, DM / 64>(lds, g, S, E); }
        grid_barrier(lds);
        { KParams KP = get_params(); unsigned char* ws = KP->ws;
          pg8::Gemm g{(const bf16_t*)(ws + WS_MRG), (const bf16_t*)(ws + WS_WOUT) + (size_t)l * DM * DM}; pg8::StaticOrder<T_TOK, DM> S; S.init(gridDim.x, blockIdx.x);
          EpiRes E{true}; pg8::gemm_phase<EpiRes, true, T_TOK, DM, DM>(lds, g, S, E); }
        grid_barrier(lds);
        { KParams KP = get_params(); unsigned char* ws = KP->ws;
          pg8::Gemm g{(const bf16_t*)(ws + WS_XB), (const bf16_t*)(ws + WS_WUP) + (size_t)l * DFF * DM}; pg8::StaticOrder<T_TOK, DFF> S; S.init(gridDim.x, blockIdx.x);
          EpiUp E{}; pg8::gemm_phase<EpiUp, true, T_TOK, DFF, DM>(lds, g, S, E); }
        grid_barrier(lds);
        { KParams KP = get_params(); unsigned char* ws = KP->ws;
          pg8::Gemm g{(const bf16_t*)(ws + WS_F), (const bf16_t*)(ws + WS_WDN) + (size_t)l * DM * DFF}; pg8::StaticOrder<T_TOK, DM> S; S.init(gridDim.x, blockIdx.x);
          EpiRes E{false}; pg8::gemm_phase<EpiRes, true, T_TOK, DM, DFF>(lds, g, S, E); }
        grid_barrier(lds);
    }
    final_norm();
}

extern "C" void kernel_launch(void* const* d_in, const int* in_sizes, int n_in, void* d_out, int out_size, void* d_ws, size_t ws_size, hipStream_t stream) {
    constexpr int LDS_BYTES = pg8::STAGE_BYTES + 64;
    static int grid_blocks = 0;
    if (grid_blocks == 0) {
        if (n_in != 14 || out_size != T_TOK * DM || ws_size < WS_END) { fprintf(stderr, "kernel_launch: unexpected shapes (n_in %d out %d ws %zu need %zu)\n", n_in, out_size, ws_size, (size_t)WS_END); grid_blocks = -1; return; }
        int dev = 0, cus = 0, per_cu = 0;
        hipGetDevice(&dev);
        hipDeviceGetAttribute(&cus, hipDeviceAttributeMultiprocessorCount, dev);
        if (hipFuncSetAttribute((const void*)fwd_kernel, hipFuncAttributeMaxDynamicSharedMemorySize, LDS_BYTES) != hipSuccess) { fprintf(stderr, "kernel_launch: hipFuncSetAttribute failed\n"); grid_blocks = -1; return; }
        if (hipOccupancyMaxActiveBlocksPerMultiprocessor(&per_cu, (const void*)fwd_kernel, 512, LDS_BYTES) != hipSuccess || per_cu < 1) { fprintf(stderr, "kernel_launch: occupancy query says %d blocks per CU\n", per_cu); per_cu = 1; }
        (void)hipGetLastError();
        grid_blocks = cus;
    }
    if (grid_blocks < 0) return;
    if (hipMemsetAsync((char*)d_ws + WS_BAR, 0, WS_BAR_BYTES, stream) != hipSuccess) { fprintf(stderr, "kernel_launch: memset of the barrier words failed\n"); return; }
    Params p{};
    for (int i = 0; i < 14; ++i) p.in[i] = (const float*)d_in[i];
    p.out = (float*)d_out; p.ws = (unsigned char*)d_ws;
    void* args[] = {&p};
    hipError_t e = hipLaunchCooperativeKernel((const void*)fwd_kernel, dim3(grid_blocks), dim3(512), args, LDS_BYTES, stream);
    if (e != hipSuccess) fprintf(stderr, "cooperative launch failed: %s (grid %d)\n", hipGetErrorString(e), grid_blocks);
}
```

```cpp
#include <hip/hip_runtime.h>
#include <hip/hip_cooperative_groups.h>
#include <cstdio>
#include <cstdint>
namespace cg = cooperative_groups;

#define LAS __attribute__((address_space(3)))
typedef unsigned short bf16_t;
typedef short bf16x8 __attribute__((ext_vector_type(8)));
typedef float f32x4 __attribute__((ext_vector_type(4)));
typedef unsigned u32x4 __attribute__((ext_vector_type(4)));
typedef unsigned u32x2 __attribute__((ext_vector_type(2)));

constexpr int T_TOK = 65536, DM = 1024, SEQ = 2048, NBATCH = 32, DEPTH = 4, DFF = 4096, INC = 4608;
constexpr float EPS = 1e-6f;

constexpr size_t SZ_TD = (size_t)T_TOK * DM * 2;
constexpr size_t WS_XB   = 0;
constexpr size_t WS_AINT = WS_XB + SZ_TD;
constexpr size_t WS_VT   = WS_AINT + SZ_TD / 2;
constexpr size_t WS_U    = WS_VT + SZ_TD;
constexpr size_t WS_GA   = WS_U + SZ_TD;
constexpr size_t WS_GB   = WS_GA + SZ_TD;
constexpr size_t WS_YA   = WS_GB + SZ_TD;
constexpr size_t WS_WIN  = WS_YA + SZ_TD;
constexpr size_t WS_WACS = WS_WIN + (size_t)DEPTH * INC * DM * 2;
constexpr size_t WS_WB   = WS_WACS + (size_t)DEPTH * DM * DM * 2;
constexpr size_t WS_WOUT = WS_WB + (size_t)DEPTH * DM * DM * 2;
constexpr size_t WS_WUP  = WS_WOUT + (size_t)DEPTH * DM * DM * 2;
constexpr size_t WS_WDN  = WS_WUP + (size_t)DEPTH * DFF * DM * 2;
constexpr size_t WS_WS   = WS_WDN + (size_t)DEPTH * DFF * DM * 2;
constexpr size_t WS_CS   = WS_WS + (size_t)DEPTH * 8 * 128 * 128 * 2;
constexpr size_t WS_RSA  = WS_CS + (size_t)SEQ * SEQ * 2;
constexpr size_t WS_RSB  = WS_RSA + (size_t)T_TOK * 16 * 4;
constexpr size_t WS_BAR  = WS_RSB + (size_t)T_TOK * 16 * 4;
constexpr size_t WS_BAR_BYTES = 16384;
constexpr size_t WS_RS2  = WS_BAR + WS_BAR_BYTES;
constexpr size_t WS_END  = WS_RS2 + (size_t)T_TOK * 4;
constexpr size_t WS_F    = WS_AINT;
constexpr size_t WS_MRG  = WS_VT;

__device__ __forceinline__ unsigned cvt_pk_bf16(float lo, float hi) { unsigned r; asm volatile("v_cvt_pk_bf16_f32 %0, %1, %2" : "=v"(r) : "v"(lo), "v"(hi)); return r; }
__device__ __forceinline__ void st_nt(void* p, const u32x4& v) { __builtin_nontemporal_store(v, (u32x4*)p); }
__device__ __forceinline__ unsigned dpp_swap1(unsigned v) { return (unsigned)__builtin_amdgcn_update_dpp(0, (int)v, 0xB1, 0xf, 0xf, true); }
__device__ __forceinline__ void pair_lines(bool odd, const u32x4& w0, const u32x4& w1, u32x4& va, u32x4& vb) {
    u32x4 snd, rcv;
    snd.x = odd ? w0.x : w1.x; snd.y = odd ? w0.y : w1.y; snd.z = odd ? w0.z : w1.z; snd.w = odd ? w0.w : w1.w;
    rcv.x = dpp_swap1(snd.x); rcv.y = dpp_swap1(snd.y); rcv.z = dpp_swap1(snd.z); rcv.w = dpp_swap1(snd.w);
    va.x = odd ? rcv.x : w0.x; va.y = odd ? rcv.y : w0.y; va.z = odd ? rcv.z : w0.z; va.w = odd ? rcv.w : w0.w;
    vb.x = odd ? w1.x : rcv.x; vb.y = odd ? w1.y : rcv.y; vb.z = odd ? w1.z : rcv.z; vb.w = odd ? w1.w : rcv.w;
}
__device__ __forceinline__ float bf_lo(unsigned w) { return __uint_as_float(w << 16); }
__device__ __forceinline__ float bf_hi(unsigned w) { return __uint_as_float(w & 0xffff0000u); }
__device__ __forceinline__ float sigmoid_f(float a) { return __builtin_amdgcn_rcpf(1.0f + __builtin_amdgcn_exp2f(-1.4426950408889634f * a)); }
__device__ __forceinline__ float gelu_tanh_f(float x) { const float t = 1.5957691216057308f * (x + 0.044715f * x * x * x); return x * sigmoid_f(t); }

namespace pg8 {
constexpr int BM = 256, BK = 64, HALF = 128, HTB = HALF * BK * 2, STAGE_BYTES = 8 * HTB, NXCD = 8, WGM = 8;
__host__ __device__ __forceinline__ int lds_byte(int r, int c) { const int st = (r >> 4) * 2 + (c >> 5), rr = r & 15, cc = c & 31, ob = rr * 64 + cc * 2; return st * 1024 + (ob ^ (((ob >> 9) & 1) << 5)); }
__host__ __device__ __forceinline__ void stage_rc(int b, int& R, int& C) { const int st = b / 1024, sb = b % 1024, swz = sb ^ (((sb >> 9) & 1) << 5); R = (st >> 1) * 16 + swz / 64; C = (st & 1) * 32 + (swz % 64) / 2; }
__host__ __device__ __forceinline__ int perm32(int rho) { const int n = rho >> 4, i = rho & 15; return 8 * (i >> 2) + 4 * n + (i & 3); }

struct Unit { int pm, pn; };
struct Gemm { const bf16_t* A; const bf16_t* Bt; const bf16_t* A2; const bf16_t* Bt2; };

template <int M, int N> struct StaticOrder {
    static constexpr int nM = M / BM, nN = N / BM, nwg = nM * nN;
    int G, c;
    __device__ void init(int G_, int c_) { G = G_; c = c_; }
    __device__ bool next(int i, Unit& u) const {
        const int L = i * G + c; if (L >= nwg) return false;
        int wgid = L; { constexpr int q = nwg / NXCD, r = nwg % NXCD; const int xcd = wgid % NXCD, off = wgid / NXCD; wgid = (xcd < r ? xcd * (q + 1) : r * (q + 1) + (xcd - r) * q) + off; }
        constexpr int nig = WGM * nN; const int gid = wgid / nig, fm = gid * WGM, gsz = (nM - fm) < WGM ? (nM - fm) : WGM;
        u.pm = fm + ((wgid % nig) % gsz); u.pn = (wgid % nig) / gsz; return true;
    }
};

template <class Epi, bool ALIGN_EPI, int M, int N, int K, int LD = K, int KSPLIT = K / BK>
__device__ __forceinline__ void gemm_phase(LAS unsigned char* lds, const Gemm g, const StaticOrder<M, N>& S, const Epi& E) {
    int tid_ = threadIdx.x; asm volatile("" : "+v"(tid_));
    const int tid = tid_, wid = __builtin_amdgcn_readfirstlane(tid >> 6), lane = tid & 63, wr = wid >> 2, wc = wid & 3, fr = lane & 15, fq = lane >> 4;
    constexpr int nt = K / BK;
    unsigned voffA, voffB;
    { int R, C; stage_rc(tid * 16, R, C); const int Rb = Epi::PERM ? (64 * (R >> 5) + perm32(R & 31)) : R;
      voffA = (unsigned)(R * LD + C) * 2u; voffB = (unsigned)(Rb * LD + C) * 2u; }
    constexpr size_t bhs = Epi::PERM ? (size_t)32 * LD * 2 : (size_t)HALF * LD * 2;
    constexpr size_t bps = Epi::PERM ? (size_t)128 * LD * 2 : (size_t)64 * LD * 2;
    constexpr size_t kstep = (size_t)(BK * 2);
    constexpr size_t hstep = (size_t)HALF * LD * 2;
    constexpr size_t tstep = 2 * hstep;
    const unsigned ldsw = (unsigned)wid * 1024u;
    const int aoff = lds_byte(wr * 64 + fr, fq * 8), boff = lds_byte(wc * 32 + fr, fq * 8);
#define PG8_SA(b, h) (((b) * 2 + (h)) * HTB)
#define PG8_SB(b, h) ((4 + (b) * 2 + (h)) * HTB)
#define PG8_STAGE(bufoff, gbase, voff) do { _Pragma("unroll") for (int _i = 0; _i < 2; ++_i) \
        __builtin_amdgcn_global_load_lds((const unsigned*)((const char*)(gbase) + (size_t)_i * (64 * LD * 2) + (voff)), (LAS unsigned*)(lds + (bufoff) + ldsw + _i * 8192), 16, 0, 0); } while (0)
#define PG8_STAGEB(bufoff, gbase, voff) do { _Pragma("unroll") for (int _i = 0; _i < 2; ++_i) \
        __builtin_amdgcn_global_load_lds((const unsigned*)((const char*)(gbase) + (size_t)_i * bps + (voff)), (LAS unsigned*)(lds + (bufoff) + ldsw + _i * 8192), 16, 0, 0); } while (0)
#define PG8_LDA(dst, b, h) do { _Pragma("unroll") for (int m = 0; m < 4; ++m) _Pragma("unroll") for (int k = 0; k < 2; ++k) dst[m][k] = *(const LAS bf16x8*)(lds + PG8_SA(b, h) + aoff + m * 2048 + k * 1024); } while (0)
#define PG8_LDB(dst, b, h) do { _Pragma("unroll") for (int n = 0; n < 2; ++n) _Pragma("unroll") for (int k = 0; k < 2; ++k) dst[n][k] = *(const LAS bf16x8*)(lds + PG8_SB(b, h) + boff + n * 2048 + k * 1024); } while (0)
#define PG8_MMA(ai, bj, At, Bt) do { __builtin_amdgcn_s_setprio(1); _Pragma("unroll") for (int m = 0; m < 4; ++m) _Pragma("unroll") for (int n = 0; n < 2; ++n) _Pragma("unroll") for (int k = 0; k < 2; ++k) \
        acc[ai][bj][m][n] = Epi::SWAP ? __builtin_amdgcn_mfma_f32_16x16x32_bf16(At[m][k], Bt[n][k], acc[ai][bj][m][n], 0, 0, 0) \
                                      : __builtin_amdgcn_mfma_f32_16x16x32_bf16(Bt[n][k], At[m][k], acc[ai][bj][m][n], 0, 0, 0); __builtin_amdgcn_s_setprio(0); } while (0)
#define PG8_WAIT_V(n) asm volatile("s_waitcnt vmcnt(" #n ")" ::: "memory")
#define PG8_WAIT_L(n) asm volatile("s_waitcnt lgkmcnt(" #n ")" ::: "memory")
#define PG8_BAR __builtin_amdgcn_s_barrier()
#define PG8_SCHED __builtin_amdgcn_sched_barrier(0)
    Unit cur, nxt; int ui = 0;
    if (!S.next(0, cur)) return;
    f32x4 acc[2][2][4][2];
#pragma unroll
    for (int a = 0; a < 2; ++a)
#pragma unroll
        for (int b = 0; b < 2; ++b)
#pragma unroll
            for (int m = 0; m < 4; ++m)
#pragma unroll
                for (int n = 0; n < 2; ++n) acc[a][b][m][n] = (f32x4){0.f, 0.f, 0.f, 0.f};
    bf16x8 At[4][2], B0[2][2], B1[2][2];
    constexpr bool SPLIT = KSPLIT < nt;
    const char* cA = (const char*)g.A + (size_t)cur.pm * tstep; const char* cB = (const char*)g.Bt + (size_t)cur.pn * tstep;
    const char* cA2 = SPLIT ? (const char*)g.A2 + (size_t)cur.pm * tstep : cA; const char* cB2 = SPLIT ? (const char*)g.Bt2 + (size_t)cur.pn * tstep : cB;
#define PG8_TA(tt) ((SPLIT && (tt) >= KSPLIT) ? cA2 + (size_t)((tt) - KSPLIT) * kstep : cA + (size_t)(tt) * kstep)
#define PG8_TB(tt) ((SPLIT && (tt) >= KSPLIT) ? cB2 + (size_t)((tt) - KSPLIT) * kstep : cB + (size_t)(tt) * kstep)
    PG8_STAGEB(PG8_SB(0, 0), cB, voffB); PG8_STAGEB(PG8_SB(0, 1), cB + bhs, voffB); PG8_STAGE(PG8_SA(0, 0), cA, voffA); PG8_STAGE(PG8_SA(0, 1), cA + hstep, voffA);
    if (wr == 1) PG8_BAR;
    PG8_WAIT_V(2); PG8_BAR;
    PG8_STAGEB(PG8_SB(1, 0), cB + kstep, voffB); PG8_STAGE(PG8_SA(1, 0), cA + kstep, voffA); PG8_STAGEB(PG8_SB(1, 1), cB + bhs + kstep, voffB);
    PG8_WAIT_V(6); PG8_BAR;
    for (;;) {
        const bool has_next = S.next(ui + 1, nxt);
        const char* nA = has_next ? (const char*)g.A + (size_t)nxt.pm * tstep : cA; const char* nB = has_next ? (const char*)g.Bt + (size_t)nxt.pn * tstep : cB;
        for (int t = 0; t < nt; t += 2) {
            const bool last = (t == nt - 2);
            const bool first = (t == 0) && (ui > 0);
            const char* a1 = PG8_TA(t + 1);
            const char* a2 = last ? nA : PG8_TA(t + 2); const char* b2 = last ? nB : PG8_TB(t + 2);
            const char* a3 = a2 + kstep; const char* b3 = b2 + kstep;
            PG8_LDB(B0, 0, 0); PG8_LDB(B1, 0, 1); PG8_SCHED; PG8_LDA(At, 0, 0); if (!first) { PG8_STAGE(PG8_SA(1, 1), a1 + hstep, voffA); PG8_WAIT_V(8); }
            PG8_WAIT_L(0); PG8_BAR; PG8_MMA(0, 0, At, B0); PG8_MMA(0, 1, At, B1); PG8_BAR; PG8_SCHED;
            PG8_LDA(At, 0, 1); PG8_STAGEB(PG8_SB(0, 0), b2, voffB); PG8_STAGEB(PG8_SB(0, 1), b2 + bhs, voffB); PG8_STAGE(PG8_SA(0, 0), a2, voffA);
            if (!first) PG8_WAIT_V(8); PG8_WAIT_L(0); PG8_BAR; PG8_MMA(1, 0, At, B0); PG8_MMA(1, 1, At, B1); PG8_BAR; PG8_SCHED;
            PG8_LDB(B0, 1, 0); PG8_LDB(B1, 1, 1); PG8_SCHED; PG8_LDA(At, 1, 0); PG8_STAGE(PG8_SA(0, 1), a2 + hstep, voffA);
            if (!first) PG8_WAIT_V(8); PG8_WAIT_L(0); PG8_BAR; PG8_MMA(0, 0, At, B0); PG8_MMA(0, 1, At, B1); PG8_BAR; PG8_SCHED;
            PG8_LDA(At, 1, 1); PG8_STAGEB(PG8_SB(1, 0), b3, voffB); PG8_STAGEB(PG8_SB(1, 1), b3 + bhs, voffB); PG8_STAGE(PG8_SA(1, 0), a3, voffA);
            if (!first) PG8_WAIT_V(8); PG8_WAIT_L(0); PG8_BAR; PG8_MMA(1, 0, At, B0); PG8_MMA(1, 1, At, B1); PG8_BAR; PG8_SCHED;
            if constexpr (SPLIT) { if (t + 2 == KSPLIT) { int fr_e = fr, fq_e = fq; asm volatile("" : "+v"(fr_e), "+v"(fq_e)); E.mid(acc, cur, wr, wc, fr_e, fq_e); } }
        }
        if constexpr (ALIGN_EPI) { if (wr == 0) PG8_BAR; }
        if (has_next) PG8_STAGE(PG8_SA(1, 1), nA + kstep + hstep, voffA);
        { int fr_e = fr, fq_e = fq; asm volatile("" : "+v"(fr_e), "+v"(fq_e));
          E(acc, cur, wr, wc, fr_e, fq_e); }
        if (!has_next) break;
#pragma unroll
        for (int a = 0; a < 2; ++a)
#pragma unroll
            for (int b = 0; b < 2; ++b)
#pragma unroll
                for (int m = 0; m < 4; ++m)
#pragma unroll
                    for (int n = 0; n < 2; ++n) acc[a][b][m][n] = (f32x4){0.f, 0.f, 0.f, 0.f};
        cur = nxt; cA = nA; cB = nB; ++ui;
        if constexpr (SPLIT) { cA2 = (const char*)g.A2 + (size_t)cur.pm * tstep; cB2 = (const char*)g.Bt2 + (size_t)cur.pn * tstep; }
        if constexpr (ALIGN_EPI) { if (wr == 1) PG8_BAR; }
    }
    PG8_WAIT_V(0);
    if constexpr (!ALIGN_EPI) { if (wr == 0) PG8_BAR; }
    PG8_BAR;
#undef PG8_TA
#undef PG8_TB
#undef PG8_STAGEB
#undef PG8_SA
#undef PG8_SB
#undef PG8_STAGE
#undef PG8_LDA
#undef PG8_LDB
#undef PG8_MMA
#undef PG8_WAIT_V
#undef PG8_WAIT_L
#undef PG8_BAR
#undef PG8_SCHED
}
}

typedef f32x4 AccT[2][2][4][2];

struct Params { const float* in[14]; float* out; unsigned char* ws; };
typedef const Params __attribute__((address_space(4))) * KParams;
__device__ __forceinline__ KParams get_params() {
    KParams p = (KParams)__builtin_amdgcn_kernarg_segment_ptr();
    asm volatile("" : "+s"(p));
    return p;
}


__device__ __forceinline__ void rows_rs8(const float* rowss, int row0  , int fq, float (&rs)[8]) {
    f32x4 t[8];
#pragma unroll
    for (int g = 0; g < 8; ++g) t[g] = *(const f32x4*)(rowss + (size_t)(row0 + (g >> 2) * 128 + (g & 3) * 16) * 16 + fq * 4);
#pragma unroll
    for (int g = 0; g < 8; ++g) {
        float s = (t[g][0] + t[g][1]) + (t[g][2] + t[g][3]);
        s += __shfl_xor(s, 16); s += __shfl_xor(s, 32);
        rs[g] = __builtin_amdgcn_rsqf(s * (1.0f / 1024.0f) + EPS);
    }
    asm volatile("s_waitcnt vmcnt(0)" ::: "memory");
}
__device__ __forceinline__ float dpp_row_sum16(float s) {
    s += __builtin_bit_cast(float, __builtin_amdgcn_update_dpp(0, __builtin_bit_cast(int, s), 0x128, 0xf, 0xf, false));
    s += __builtin_bit_cast(float, __builtin_amdgcn_update_dpp(0, __builtin_bit_cast(int, s), 0x124, 0xf, 0xf, false));
    s += __builtin_bit_cast(float, __builtin_amdgcn_update_dpp(0, __builtin_bit_cast(int, s), 0x122, 0xf, 0xf, false));
    s += __builtin_bit_cast(float, __builtin_amdgcn_update_dpp(0, __builtin_bit_cast(int, s), 0x121, 0xf, 0xf, false));
    return s;
}

struct EpiIn {
    static constexpr bool PERM = true, SWAP = false;
    __device__ __forceinline__ void operator()(const AccT& acc, const pg8::Unit& u, int wr, int wc, int fr, int fq) const {
        unsigned char* ws = get_params()->ws; bf16_t* U = (bf16_t*)(ws + WS_U); const float* rowss = (const float*)(ws + WS_RSA);
        const int t = u.pn >> 2;
        bf16_t* base = U + (size_t)t * T_TOK * DM;
        const int col0 = (u.pn & 3) * 256 + wc * 64 + 8 * fq;
        const int row0 = u.pm * 256 + wr * 64 + fr;
        float rsv[8]; rows_rs8(rowss, row0, fq, rsv);
#pragma unroll
        for (int ai = 0; ai < 2; ++ai)
#pragma unroll
            for (int m = 0; m < 4; ++m) {
                const int row = row0 + ai * 128 + m * 16;
                const float rs = rsv[ai * 4 + m];
                u32x4 wq[2];
#pragma unroll
                for (int bj = 0; bj < 2; ++bj) {
                    float v[8];
#pragma unroll
                    for (int j = 0; j < 4; ++j) { v[j] = acc[ai][bj][m][0][j] * rs; v[4 + j] = acc[ai][bj][m][1][j] * rs; }
                    if (t == 0) {
#pragma unroll
                        for (int j = 0; j < 8; ++j) v[j] = gelu_tanh_f(v[j]);
                    } else {
#pragma unroll
                        for (int j = 0; j < 8; ++j) v[j] = sigmoid_f(v[j]);
                    }
                    wq[bj].x = cvt_pk_bf16(v[0], v[1]); wq[bj].y = cvt_pk_bf16(v[2], v[3]); wq[bj].z = cvt_pk_bf16(v[4], v[5]); wq[bj].w = cvt_pk_bf16(v[6], v[7]);
                }
                const bool odd = fr & 1; u32x4 va, vb; pair_lines(odd, wq[0], wq[1], va, vb);
                bf16_t* pa = base + (size_t)(row & ~1) * DM + col0 + (odd ? 32 : 0);
                st_nt(pa, va); st_nt(pa + DM, vb);
            }
    }
};

struct EpiInT {
    static constexpr bool PERM = false, SWAP = true;
    __device__ __forceinline__ void operator()(const AccT& acc, const pg8::Unit& u, int wr, int wc, int fr, int fq) const {
        unsigned char* ws = get_params()->ws; bf16_t* AinT = (bf16_t*)(ws + WS_AINT); bf16_t* VT = (bf16_t*)(ws + WS_VT); const float* rowss = (const float*)(ws + WS_RSA);
        const int b = u.pm >> 3, n0 = (u.pm & 7) * 256;
        const bool isv = u.pn >= 2;
        bf16_t* base = isv ? VT + ((size_t)b * 1024 + (size_t)(u.pn - 2) * 256) * SEQ : AinT + ((size_t)b * 512 + (size_t)u.pn * 256) * SEQ;
        float rsv[32];
#pragma unroll
        for (int g = 0; g < 8; ++g)
#pragma unroll
            for (int j = 0; j < 4; ++j) rsv[g * 4 + j] = rowss[(size_t)(u.pm * 256 + (g >> 2) * 128 + wr * 64 + (g & 3) * 16 + 4 * fq + j) * 16 + fr];
#pragma unroll
        for (int i = 0; i < 32; ++i) rsv[i] = __builtin_amdgcn_rsqf(dpp_row_sum16(rsv[i]) * (1.0f / 1024.0f) + EPS);
        asm volatile("s_waitcnt vmcnt(0)" ::: "memory");
#pragma unroll
        for (int ai = 0; ai < 2; ++ai)
#pragma unroll
            for (int m = 0; m < 4; ++m) {
                const int rl = ai * 128 + wr * 64 + m * 16 + 4 * fq;
#pragma unroll
                for (int bj = 0; bj < 2; ++bj) {
                    u32x2 wn[2];
#pragma unroll
                    for (int n = 0; n < 2; ++n) {
                        float v[4];
#pragma unroll
                        for (int j = 0; j < 4; ++j) v[j] = acc[ai][bj][m][n][j] * rsv[(ai * 4 + m) * 4 + j];
                        if (isv) {
#pragma unroll
                            for (int j = 0; j < 4; ++j) v[j] = gelu_tanh_f(v[j]);
                        }
                        wn[n].x = cvt_pk_bf16(v[0], v[1]); wn[n].y = cvt_pk_bf16(v[2], v[3]);
                    }
                    const u32x2 sx = __builtin_amdgcn_permlane16_swap(wn[0].x, wn[1].x, false, false);
                    const u32x2 sy = __builtin_amdgcn_permlane16_swap(wn[0].y, wn[1].y, false, false);
                    u32x4 w; w.x = sx.x; w.y = sy.x; w.z = sx.y; w.w = sy.y;
                    const int cl = bj * 128 + wc * 32 + (fq & 1) * 16 + fr;
                    *(u32x4*)(base + (size_t)cl * SEQ + n0 + rl - (fq & 1) * 4) = w;
                }
            }
    }
};

struct EpiDft {
    static constexpr bool PERM = true, SWAP = false;
    __device__ __forceinline__ void operator()(const AccT& acc, const pg8::Unit& u, int wr, int wc, int fr, int fq) const {
        bf16_t* YA = (bf16_t*)(get_params()->ws + WS_YA);
        const int b = u.pn >> 1;
        const int c0 = (u.pn & 1) * 256 + wc * 64 + 8 * fq;
        bf16_t* yb = YA + (size_t)b * SEQ * DM;
        asm volatile("s_waitcnt vmcnt(0)" ::: "memory");
#pragma unroll
        for (int ai = 0; ai < 2; ++ai)
#pragma unroll
            for (int m = 0; m < 4; ++m) {
                const int r = u.pm * 256 + ai * 128 + wr * 64 + m * 16 + fr;
#pragma unroll
                for (int bj = 0; bj < 2; ++bj) {
                    const f32x4 a0 = acc[ai][bj][m][0], a1 = acc[ai][bj][m][1];
                    u32x4 w; w.x = cvt_pk_bf16(a0[0], a0[1]); w.y = cvt_pk_bf16(a0[2], a0[3]); w.z = cvt_pk_bf16(a1[0], a1[1]); w.w = cvt_pk_bf16(a1[2], a1[3]);
                    const int c = c0 + bj * 32;
                    if (r <= 1024) {
                        *(u32x4*)(yb + (size_t)r * DM + c) = w;
                        if (r != 0 && r != 1024) *(u32x4*)(yb + (size_t)(SEQ - r) * DM + c) = w;
                        else *(u32x4*)(yb + (size_t)r * DM + 512 + c) = (u32x4){0u, 0u, 0u, 0u};
                    } else {
                        const int kk = r - 1024;
                        *(u32x4*)(yb + (size_t)kk * DM + 512 + c) = w;
                        u32x4 wn; wn.x = w.x ^ 0x80008000u; wn.y = w.y ^ 0x80008000u; wn.z = w.z ^ 0x80008000u; wn.w = w.w ^ 0x80008000u;
                        *(u32x4*)(yb + (size_t)(SEQ - kk) * DM + 512 + c) = wn;
                    }
                }
            }
    }
};

struct EpiGateM {
    static constexpr bool PERM = true, SWAP = false;
    __device__ __forceinline__ void mid(AccT& acc, const pg8::Unit& u, int wr, int wc, int fr, int fq) const {
        unsigned char* ws = get_params()->ws; const bf16_t* GA = (const bf16_t*)(ws + WS_GA); const bf16_t* GB = (const bf16_t*)(ws + WS_GB);
        const size_t off0 = (size_t)(u.pm * 256 + wr * 64 + fr) * DM + u.pn * 256 + wc * 64 + 8 * fq;
#pragma unroll
        for (int ai = 0; ai < 2; ++ai) {
            u32x4 ga[4][2], gb[4][2];
#pragma unroll
            for (int m = 0; m < 4; ++m)
#pragma unroll
                for (int bj = 0; bj < 2; ++bj) {
                    const size_t off = off0 + (size_t)(ai * 128 + m * 16) * DM + bj * 32;
                    ga[m][bj] = *(const u32x4*)(GA + off); gb[m][bj] = *(const u32x4*)(GB + off);
                }
            asm volatile("s_waitcnt vmcnt(0)" ::: "memory");
#pragma unroll
            for (int m = 0; m < 4; ++m)
#pragma unroll
                for (int bj = 0; bj < 2; ++bj) {
                    const u32x4 a4 = ga[m][bj], b4 = gb[m][bj];
                    float r[8];
                    r[0] = bf_lo(a4.x) * __builtin_amdgcn_rcpf(fmaxf(bf_lo(b4.x), 1e-20f)); r[1] = bf_hi(a4.x) * __builtin_amdgcn_rcpf(fmaxf(bf_hi(b4.x), 1e-20f));
                    r[2] = bf_lo(a4.y) * __builtin_amdgcn_rcpf(fmaxf(bf_lo(b4.y), 1e-20f)); r[3] = bf_hi(a4.y) * __builtin_amdgcn_rcpf(fmaxf(bf_hi(b4.y), 1e-20f));
                    r[4] = bf_lo(a4.z) * __builtin_amdgcn_rcpf(fmaxf(bf_lo(b4.z), 1e-20f)); r[5] = bf_hi(a4.z) * __builtin_amdgcn_rcpf(fmaxf(bf_hi(b4.z), 1e-20f));
                    r[6] = bf_lo(a4.w) * __builtin_amdgcn_rcpf(fmaxf(bf_lo(b4.w), 1e-20f)); r[7] = bf_hi(a4.w) * __builtin_amdgcn_rcpf(fmaxf(bf_hi(b4.w), 1e-20f));
#pragma unroll
                    for (int j = 0; j < 4; ++j) { acc[ai][bj][m][0][j] *= r[j]; acc[ai][bj][m][1][j] *= r[4 + j]; }
                }
        }
    }
    __device__ __forceinline__ void operator()(const AccT& acc, const pg8::Unit& u, int wr, int wc, int fr, int fq) const {
        unsigned char* ws = get_params()->ws; const bf16_t* GB = (const bf16_t*)(ws + WS_GB); bf16_t* MRG = (bf16_t*)(ws + WS_MRG);
        const size_t off0 = (size_t)(u.pm * 256 + wr * 64 + fr) * DM + u.pn * 256 + wc * 64 + 8 * fq;
        u32x4 gb[8][2];
#pragma unroll
        for (int g = 0; g < 8; ++g)
#pragma unroll
            for (int bj = 0; bj < 2; ++bj) gb[g][bj] = *(const u32x4*)(GB + off0 + (size_t)((g >> 2) * 128 + (g & 3) * 16) * DM + bj * 32);
        asm volatile("s_waitcnt vmcnt(0)" ::: "memory");
        const bool odd = fr & 1;
#pragma unroll
        for (int g = 0; g < 8; ++g) {
            const int ai = g >> 2, m = g & 3;
            u32x4 wq[2];
#pragma unroll
            for (int bj = 0; bj < 2; ++bj) {
                const u32x4 b4 = gb[g][bj];
                const f32x4 a0 = acc[ai][bj][m][0], a1 = acc[ai][bj][m][1];
                wq[bj].x = cvt_pk_bf16(a0[0] * fmaxf(bf_lo(b4.x), 1e-20f), a0[1] * fmaxf(bf_hi(b4.x), 1e-20f)); wq[bj].y = cvt_pk_bf16(a0[2] * fmaxf(bf_lo(b4.y), 1e-20f), a0[3] * fmaxf(bf_hi(b4.y), 1e-20f));
                wq[bj].z = cvt_pk_bf16(a1[0] * fmaxf(bf_lo(b4.z), 1e-20f), a1[1] * fmaxf(bf_hi(b4.z), 1e-20f)); wq[bj].w = cvt_pk_bf16(a1[2] * fmaxf(bf_lo(b4.w), 1e-20f), a1[3] * fmaxf(bf_hi(b4.w), 1e-20f));
            }
            u32x4 va, vb; pair_lines(odd, wq[0], wq[1], va, vb);
            bf16_t* pa = MRG + ((long)off0 + (long)(ai * 128 + m * 16 - (odd ? 1 : 0)) * DM + (odd ? 32 : 0));
            *(u32x4*)pa = va; *(u32x4*)(pa + DM) = vb;
        }
    }
};

struct EpiRes {
    static constexpr bool PERM = true, SWAP = false;
    bool to_b;
    __device__ __forceinline__ void operator()(const AccT& acc, const pg8::Unit& u, int wr, int wc, int fr, int fq) const {
        unsigned char* ws = get_params()->ws; bf16_t* XB = (bf16_t*)(ws + WS_XB); float* rowss = (float*)(ws + (to_b ? WS_RSB : WS_RSA));
        const int col0 = u.pn * 256 + wc * 64 + 8 * fq;
        const int row0 = u.pm * 256 + wr * 64 + fr;
        u32x4 xv[8][2]; float sc2[8];
#pragma unroll
        for (int g = 0; g < 8; ++g)
#pragma unroll
            for (int bj = 0; bj < 2; ++bj) xv[g][bj] = *(const u32x4*)(XB + (size_t)(row0 + (g >> 2) * 128 + (g & 3) * 16) * DM + col0 + bj * 32);
        if (!to_b) {
            const float* rs2 = (const float*)(ws + WS_RS2);
#pragma unroll
            for (int g = 0; g < 8; ++g) sc2[g] = rs2[row0 + (g >> 2) * 128 + (g & 3) * 16];
        } else {
#pragma unroll
            for (int g = 0; g < 8; ++g) sc2[g] = 1.0f;
        }
        asm volatile("s_waitcnt vmcnt(0)" ::: "memory");
        float ssv[8];
#pragma unroll
        for (int g = 0; g < 8; ++g) {
            const int ai = g >> 2, m = g & 3;
            const int row = row0 + ai * 128 + m * 16;
            float ss = 0.f;
#pragma unroll
            for (int bj = 0; bj < 2; ++bj) {
                const u32x4 x4 = xv[g][bj];
                const f32x4 a0 = acc[ai][bj][m][0] * sc2[g], a1 = acc[ai][bj][m][1] * sc2[g];
                u32x4 w;
                w.x = cvt_pk_bf16(bf_lo(x4.x) + a0[0], bf_hi(x4.x) + a0[1]); w.y = cvt_pk_bf16(bf_lo(x4.y) + a0[2], bf_hi(x4.y) + a0[3]);
                w.z = cvt_pk_bf16(bf_lo(x4.z) + a1[0], bf_hi(x4.z) + a1[1]); w.w = cvt_pk_bf16(bf_lo(x4.w) + a1[2], bf_hi(x4.w) + a1[3]);
                *(u32x4*)(XB + (size_t)row * DM + col0 + bj * 32) = w;
                const float y0 = bf_lo(w.x), y1 = bf_hi(w.x), y2 = bf_lo(w.y), y3 = bf_hi(w.y), y4 = bf_lo(w.z), y5 = bf_hi(w.z), y6 = bf_lo(w.w), y7 = bf_hi(w.w);
                ss += (y0 * y0 + y1 * y1) + (y2 * y2 + y3 * y3) + (y4 * y4 + y5 * y5) + (y6 * y6 + y7 * y7);
            }
            ss += __shfl_xor(ss, 16); ss += __shfl_xor(ss, 32);
            ssv[g] = ss;
        }
        const float sa = fq == 0 ? ssv[0] : (fq == 1 ? ssv[2] : (fq == 2 ? ssv[4] : ssv[6]));
        const float sb = fq == 0 ? ssv[1] : (fq == 1 ? ssv[3] : (fq == 2 ? ssv[5] : ssv[7]));
        const int ga = 2 * fq, gb = 2 * fq + 1;
        rowss[(size_t)(row0 + (ga >> 2) * 128 + (ga & 3) * 16) * 16 + u.pn * 4 + wc] = sa;
        rowss[(size_t)(row0 + (gb >> 2) * 128 + (gb & 3) * 16) * 16 + u.pn * 4 + wc] = sb;
    }
};

struct EpiUp {
    static constexpr bool PERM = true, SWAP = false;
    __device__ __forceinline__ void operator()(const AccT& acc, const pg8::Unit& u, int wr, int wc, int fr, int fq) const {
        unsigned char* ws = get_params()->ws; bf16_t* F = (bf16_t*)(ws + WS_F);
        const int col0 = u.pn * 256 + wc * 64 + 8 * fq;
        const int row0 = u.pm * 256 + wr * 64 + fr;
        if (u.pn == 0 && wc == 0) {
            float rsv[8]; rows_rs8((const float*)(ws + WS_RSB), row0, fq, rsv);
            const float sa = fq == 0 ? rsv[0] : (fq == 1 ? rsv[2] : (fq == 2 ? rsv[4] : rsv[6]));
            const float sb = fq == 0 ? rsv[1] : (fq == 1 ? rsv[3] : (fq == 2 ? rsv[5] : rsv[7]));
            const int ga = 2 * fq, gb = 2 * fq + 1;
            float* rs2 = (float*)(ws + WS_RS2);
            rs2[row0 + (ga >> 2) * 128 + (ga & 3) * 16] = sa * sa;
            rs2[row0 + (gb >> 2) * 128 + (gb & 3) * 16] = sb * sb;
        } else {
            asm volatile("s_waitcnt vmcnt(0)" ::: "memory");
        }
        const bool odd = fr & 1;
#pragma unroll
        for (int ai = 0; ai < 2; ++ai)
#pragma unroll
            for (int m = 0; m < 4; ++m) {
                const int row = row0 + ai * 128 + m * 16;
                u32x4 wq[2];
#pragma unroll
                for (int bj = 0; bj < 2; ++bj) {
                    float v[8];
#pragma unroll
                    for (int j = 0; j < 4; ++j) { const float r0 = fmaxf(acc[ai][bj][m][0][j], 0.f), r1 = fmaxf(acc[ai][bj][m][1][j], 0.f); v[j] = r0 * r0; v[4 + j] = r1 * r1; }
                    wq[bj].x = cvt_pk_bf16(v[0], v[1]); wq[bj].y = cvt_pk_bf16(v[2], v[3]); wq[bj].z = cvt_pk_bf16(v[4], v[5]); wq[bj].w = cvt_pk_bf16(v[6], v[7]);
                }
                u32x4 va, vb; pair_lines(odd, wq[0], wq[1], va, vb);
                bf16_t* pa = F + (size_t)(row & ~1) * DFF + col0 + (odd ? 32 : 0);
                st_nt(pa, va); st_nt(pa + DFF, vb);
            }
    }
};

#define XB_TMO      128
#define XB_XCNT(j)  (256  + 64 * (j))
#define XB_XSUB(j)  (1280 + 64 * (j))
#define XB_XGEN(j)  (2304 + 64 * (j))
#define XB_TOP      3328
#define XB_TOPGEN   3392
#define XB_SPIN_CAP (1u << 22)
constexpr int LDS_BAR_OFF = 131072;
__device__ __forceinline__ unsigned xb_ld(unsigned* p)              { return __hip_atomic_load(p, __ATOMIC_RELAXED, __HIP_MEMORY_SCOPE_AGENT); }
__device__ __forceinline__ unsigned xb_add(unsigned* p, unsigned v) { return __hip_atomic_fetch_add(p, v, __ATOMIC_RELAXED, __HIP_MEMORY_SCOPE_AGENT); }
__device__ __forceinline__ unsigned xb_xcc_id() { return (unsigned)__builtin_amdgcn_s_getreg((3 << 11) | 20) & 0xFu; }
#define XB_SPIN(cond, bar) do { unsigned _sp = 0; while (cond) { __builtin_amdgcn_s_sleep(1); \
    if ((++_sp & 255u) == 0u) { if (xb_ld(&(bar)[XB_TMO])) break; if (_sp > XB_SPIN_CAP) { atomicAdd(&(bar)[XB_TMO], 1u); break; } } } } while (0)
__device__ __forceinline__ void xcd_barrier_complete(unsigned* bar, unsigned x, unsigned& nloc, unsigned& nx) {
    const unsigned G = gridDim.x;
    unsigned sum, cnt, mine, sp = 0u;
    for (;;) {
        sum = 0u; cnt = 0u; mine = 0u;
#pragma unroll
        for (unsigned j = 0; j < 16; ++j) { const unsigned c = xb_ld(&bar[XB_XCNT(j)]); sum += c; cnt += (c > 0u) ? 1u : 0u; mine = (j == x) ? c : mine; }
        if (sum == G) break;
        __builtin_amdgcn_s_sleep(1);
        if ((++sp & 255u) == 0u) { if (xb_ld(&bar[XB_TMO])) break; if (sp > XB_SPIN_CAP) { atomicAdd(&bar[XB_TMO], 1u); break; } }
    }
    nloc = mine > 0u ? mine : 1u; nx = cnt > 0u ? cnt : 1u;
}
__device__ __forceinline__ void grid_barrier_post(LAS unsigned char* lds) {
    unsigned* bar = (unsigned*)(get_params()->ws + WS_BAR);
    if (threadIdx.x == 0) {
        volatile LAS unsigned* st = (volatile LAS unsigned*)(lds + LDS_BAR_OFF); st[0] = 0u; st[1] = 0u;
        (void)xb_add(&bar[XB_XCNT(xb_xcc_id())], 1u);
    }
    __syncthreads();
}
__device__ __forceinline__ void grid_barrier(LAS unsigned char* lds) {
    asm volatile("s_waitcnt vmcnt(0)" ::: "memory");
    unsigned* bar = (unsigned*)(get_params()->ws + WS_BAR);
    __syncthreads();
    if (threadIdx.x == 0) {
        volatile LAS unsigned* st = (volatile LAS unsigned*)(lds + LDS_BAR_OFF);
        const unsigned x = xb_xcc_id();
        __builtin_amdgcn_s_waitcnt(0);
        unsigned nloc = st[0], nx = st[1];
        if (nloc == 0u) { xcd_barrier_complete(bar, x, nloc, nx); st[0] = nloc; st[1] = nx; }
        const unsigned old = xb_add(&bar[XB_XSUB(x)], 1u);
        const unsigned gen = old / nloc;
        if (old + 1u == (gen + 1u) * nloc) {
            __builtin_amdgcn_fence(__ATOMIC_RELEASE, "agent");
            asm volatile("s_waitcnt vmcnt(0)" ::: "memory");
            const unsigned og = xb_add(&bar[XB_TOP], 1u);
            const unsigned tg = og / nx;
            if (og + 1u == (tg + 1u) * nx) xb_add(&bar[XB_TOPGEN], 1u);
            else XB_SPIN(xb_ld(&bar[XB_TOPGEN]) == tg, bar);
            __builtin_amdgcn_fence(__ATOMIC_ACQUIRE, "agent");
            xb_add(&bar[XB_XGEN(x)], 1u);
            asm volatile("s_waitcnt vmcnt(0)" ::: "memory");
        } else {
            XB_SPIN(xb_ld(&bar[XB_XGEN(x)]) == gen, bar);
            __builtin_amdgcn_fence(__ATOMIC_ACQUIRE, "agent");
            asm volatile("s_waitcnt vmcnt(0)" ::: "memory");
        }
    }
    __syncthreads();
}

struct ConvItem { const float* src; bf16_t* dst; const float* scale; int ldn, ldk, k0, n0, rowmode; };
__device__ __forceinline__ ConvItem conv_decode(KParams KP, unsigned char* ws, int it) {
    constexpr int T_IN = 16 * 72, T_SQ = 16 * 16, T_UP = 16 * 64, T_DN = 64 * 16, T_L = T_IN + 2 * T_SQ + T_UP + T_DN;
    const int l = it / T_L; int r = it % T_L; ConvItem c;
    if (r < T_IN) { c.src = KP->in[2] + (size_t)l * DM * INC; c.ldn = INC; c.dst = (bf16_t*)(ws + WS_WIN) + (size_t)l * INC * DM; c.ldk = DM; c.k0 = (r / 72) * 64; c.n0 = (r % 72) * 64; c.scale = KP->in[1] + l * DM; c.rowmode = 1; return c; } r -= T_IN;
    if (r < T_SQ) { c.src = KP->in[8] + (size_t)l * DM * DM; c.ldn = DM; c.dst = (bf16_t*)(ws + WS_WB) + (size_t)l * DM * DM; c.ldk = DM; c.k0 = (r / 16) * 64; c.n0 = (r % 16) * 64; c.scale = nullptr; c.rowmode = 0; return c; } r -= T_SQ;
    if (r < T_SQ) { c.src = KP->in[9] + (size_t)l * DM * DM; c.ldn = DM; c.dst = (bf16_t*)(ws + WS_WOUT) + (size_t)l * DM * DM; c.ldk = DM; c.k0 = (r / 16) * 64; c.n0 = (r % 16) * 64; c.scale = nullptr; c.rowmode = 0; return c; } r -= T_SQ;
    if (r < T_UP) { c.src = KP->in[11] + (size_t)l * DM * DFF; c.ldn = DFF; c.dst = (bf16_t*)(ws + WS_WUP) + (size_t)l * DFF * DM; c.ldk = DM; c.k0 = (r / 64) * 64; c.n0 = (r % 64) * 64; c.scale = KP->in[10] + l * DM; c.rowmode = 0; return c; } r -= T_UP;
    c.src = KP->in[12] + (size_t)l * DFF * DM; c.ldn = DM; c.dst = (bf16_t*)(ws + WS_WDN) + (size_t)l * DM * DFF; c.ldk = DFF; c.k0 = (r / 16) * 64; c.n0 = (r % 16) * 64; c.scale = nullptr; c.rowmode = 0; return c;
}
__device__ __forceinline__ void conv_load(int tid, const ConvItem& c, f32x4& a, f32x4& b, float& sc) {
    const int k = tid >> 3, piece = (tid & 7) * 8;
    const float* s = c.src + (size_t)(c.k0 + k) * c.ldn + c.n0 + piece;
    a = *(const f32x4*)s; b = *(const f32x4*)(s + 4);
    sc = c.scale ? c.scale[c.k0 + k] : 1.0f;
}
__device__ __forceinline__ void conv_to_lds(int tid, LAS float* tile, const f32x4& a, const f32x4& b, float sc) {
    const int k = tid >> 3, piece = (tid & 7) * 8;
    LAS float* t = tile + k * 65 + piece;
    t[0] = a[0] * sc; t[1] = a[1] * sc; t[2] = a[2] * sc; t[3] = a[3] * sc; t[4] = b[0] * sc; t[5] = b[1] * sc; t[6] = b[2] * sc; t[7] = b[3] * sc;
}
__device__ __forceinline__ void conv_store(int tid, LAS float* tile, const ConvItem& c) {
    const int nl = tid >> 3, kp = (tid & 7) * 8;
    float v[8];
#pragma unroll
    for (int j = 0; j < 8; ++j) v[j] = tile[(kp + j) * 65 + nl];
    int n = c.n0 + nl;
    if (c.rowmode == 1) { if (n >= 512 && n < 1536) n += 1024; else if (n >= 1536 && n < 2560) n -= 1024; }
    u32x4 w; w.x = cvt_pk_bf16(v[0], v[1]); w.y = cvt_pk_bf16(v[2], v[3]); w.z = cvt_pk_bf16(v[4], v[5]); w.w = cvt_pk_bf16(v[6], v[7]);
    *(u32x4*)(c.dst + (size_t)n * c.ldk + c.k0 + kp) = w;
}

__device__ __forceinline__ void wacs_tile(int tid, LAS float* tile, const float* wa_l, bf16_t* dst_l, int g, int dblk) {
    LAS float* trig = tile + 64 * 65;
    {
        const int m = tid >> 3, piece = (tid & 7) * 8;
        const float* s = wa_l + (size_t)(g * 64 + m) * DM + dblk * 64 + piece;
        const f32x4 a = *(const f32x4*)s, b = *(const f32x4*)(s + 4);
        LAS float* t = tile + m * 65 + piece;
        t[0] = a[0]; t[1] = a[1]; t[2] = a[2]; t[3] = a[3]; t[4] = b[0]; t[5] = b[1]; t[6] = b[2]; t[7] = b[3];
        if (tid < 64) { trig[tid] = cospif((float)tid * (1.0f / 32.0f)); trig[64 + tid] = sinpif((float)tid * (1.0f / 32.0f)); }
    }
    __syncthreads();
    {
        const int dl = tid >> 3, cp = (tid & 7) * 8;
        const float scale = 0.0027621358640099515f;
        float oc[8], os[8];
#pragma unroll
        for (int j = 0; j < 8; ++j) { oc[j] = 0.f; os[j] = 0.f; }
        for (int m = 0; m < 64; ++m) {
            const float w = tile[m * 65 + dl];
#pragma unroll
            for (int j = 0; j < 8; ++j) { const int idx = ((cp + j) * m) & 63; oc[j] += trig[idx] * w; os[j] += trig[64 + idx] * w; }
        }
        bf16_t* row = dst_l + (size_t)(dblk * 64 + dl) * DM + g * 64 + cp;
        u32x4 w; w.x = cvt_pk_bf16(oc[0] * scale, oc[1] * scale); w.y = cvt_pk_bf16(oc[2] * scale, oc[3] * scale); w.z = cvt_pk_bf16(oc[4] * scale, oc[5] * scale); w.w = cvt_pk_bf16(oc[6] * scale, oc[7] * scale);
        *(u32x4*)row = w;
        u32x4 z; z.x = cvt_pk_bf16(-os[0] * scale, -os[1] * scale); z.y = cvt_pk_bf16(-os[2] * scale, -os[3] * scale); z.z = cvt_pk_bf16(-os[4] * scale, -os[5] * scale); z.w = cvt_pk_bf16(-os[6] * scale, -os[7] * scale);
        *(u32x4*)(row + 512) = z;
    }
    __syncthreads();
}

__device__ __forceinline__ void prologue(LAS unsigned char* lds) {
    LAS float* tile = (LAS float*)lds;
    KParams KP = get_params();
    unsigned char* ws = KP->ws;
    int tid_ = threadIdx.x; asm volatile("" : "+v"(tid_));
    const int G = gridDim.x, bid = blockIdx.x, tid = tid_;
    {
        constexpr int T_ALL = DEPTH * (16 * 72 + 2 * 16 * 16 + 16 * 64 + 64 * 16);
        int it = bid; f32x4 ra, rb; float rsc = 1.f;
        if (it < T_ALL) { const ConvItem c = conv_decode(KP, ws, it); conv_load(tid, c, ra, rb, rsc); }
        while (it < T_ALL) {
            conv_to_lds(tid, tile, ra, rb, rsc);
            __syncthreads();
            const int nx = it + G;
            if (nx < T_ALL) { const ConvItem cn = conv_decode(KP, ws, nx); conv_load(tid, cn, ra, rb, rsc); }
            { const ConvItem c = conv_decode(KP, ws, it); conv_store(tid, tile, c); }
            __syncthreads();
            it = nx;
        }
    }
    for (int it = bid; it < DEPTH * 8 * 16; it += G) {
        const int l = it >> 7, g = (it >> 4) & 7, dblk = it & 15;
        wacs_tile(tid, tile, KP->in[3] + (size_t)l * 512 * DM, (bf16_t*)(ws + WS_WACS) + (size_t)l * DM * DM, g, dblk);
    }
    const size_t gt = (size_t)bid * 512 + tid, GT = (size_t)G * 512;
    {
        const float* src = KP->in[6]; bf16_t* dst = (bf16_t*)(ws + WS_WS);
        for (size_t i = gt; i < (size_t)DEPTH * 8 * 128 * 128 / 8; i += GT) {
            const f32x4 a = *(const f32x4*)(src + i * 8), b = *(const f32x4*)(src + i * 8 + 4);
            u32x4 w; w.x = cvt_pk_bf16(a[0], a[1]); w.y = cvt_pk_bf16(a[2], a[3]); w.z = cvt_pk_bf16(b[0], b[1]); w.w = cvt_pk_bf16(b[2], b[3]);
            *(u32x4*)(dst + i * 8) = w;
        }
        bf16_t* cs = (bf16_t*)(ws + WS_CS);
        for (size_t i = gt; i < (size_t)SEQ * SEQ / 8; i += GT) {
            const int r = (int)(i >> 8), n0 = (int)(i & 255) * 8;
            float v[8];
#pragma unroll
            for (int j = 0; j < 8; ++j) {
                const int n = n0 + j;
                if (r <= 1024) v[j] = cospif((float)((r * n) & 2047) * (1.0f / 1024.0f));
                else v[j] = sinpif((float)(((r - 1024) * n) & 2047) * (1.0f / 1024.0f));
            }
            u32x4 w; w.x = cvt_pk_bf16(v[0], v[1]); w.y = cvt_pk_bf16(v[2], v[3]); w.z = cvt_pk_bf16(v[4], v[5]); w.w = cvt_pk_bf16(v[6], v[7]);
            *(u32x4*)(cs + i * 8) = w;
        }
    }
    {
        const int lane = tid & 63, gw = bid * 8 + (tid >> 6), NGW = G * 8;
        const float* x = KP->in[0]; bf16_t* xb = (bf16_t*)(ws + WS_XB); float* rsa = (float*)(ws + WS_RSA);
        for (int row0 = gw * 2; row0 < T_TOK; row0 += NGW * 2) {
            f32x4 v[2][4];
#pragma unroll
            for (int r = 0; r < 2; ++r) { const float* xr = x + (size_t)(row0 + r) * DM + lane * 16;
                v[r][0] = *(const f32x4*)xr; v[r][1] = *(const f32x4*)(xr + 4); v[r][2] = *(const f32x4*)(xr + 8); v[r][3] = *(const f32x4*)(xr + 12); }
#pragma unroll
            for (int r = 0; r < 2; ++r) {
                const f32x4 a = v[r][0], b = v[r][1], c = v[r][2], d = v[r][3];
                float ss = (a[0] * a[0] + a[1] * a[1]) + (a[2] * a[2] + a[3] * a[3]) + (b[0] * b[0] + b[1] * b[1]) + (b[2] * b[2] + b[3] * b[3])
                         + (c[0] * c[0] + c[1] * c[1]) + (c[2] * c[2] + c[3] * c[3]) + (d[0] * d[0] + d[1] * d[1]) + (d[2] * d[2] + d[3] * d[3]);
#pragma unroll
                for (int o = 32; o >= 1; o >>= 1) ss += __shfl_xor(ss, o);
                u32x4 w0, w1; w0.x = cvt_pk_bf16(a[0], a[1]); w0.y = cvt_pk_bf16(a[2], a[3]); w0.z = cvt_pk_bf16(b[0], b[1]); w0.w = cvt_pk_bf16(b[2], b[3]);
                w1.x = cvt_pk_bf16(c[0], c[1]); w1.y = cvt_pk_bf16(c[2], c[3]); w1.z = cvt_pk_bf16(d[0], d[1]); w1.w = cvt_pk_bf16(d[2], d[3]);
                bf16_t* o = xb + (size_t)(row0 + r) * DM + lane * 16;
                *(u32x4*)o = w0; *(u32x4*)(o + 8) = w1;
                if (lane < 16) rsa[(size_t)(row0 + r) * 16 + lane] = lane == 0 ? ss : 0.f;
            }
        }
    }
}

__device__ __forceinline__ void sgu_phase(LAS unsigned char* lds, int layer) {
    KParams KP = get_params();
    int tid_ = threadIdx.x; asm volatile("" : "+v"(tid_));
    const int tid = tid_, lane = tid & 63, wave = tid >> 6, fr = lane & 15, fq = lane >> 4;
    LAS float* red = (LAS float*)lds;
    LAS float* stat = (LAS float*)(lds + 8192);
    LAS float* gbl = (LAS float*)(lds + 16384);
    unsigned char* ws = KP->ws;
    const bf16_t* VT = (const bf16_t*)(ws + WS_VT);
    bf16_t* U = (bf16_t*)(ws + WS_U);
    const bf16_t* WSB = (const bf16_t*)(ws + WS_WS) + (size_t)layer * 8 * 128 * 128;
    { const float* lng = KP->in[4] + layer * DM; const float* lnb = KP->in[5] + layer * DM; const float* bs = KP->in[7] + layer * 8 * 128;
      for (int i = tid; i < 1024; i += 512) { gbl[i] = lng[i]; gbl[1024 + i] = lnb[i]; gbl[2048 + i] = bs[i]; } }
    __syncthreads();
    for (int unit = blockIdx.x; unit < NBATCH * 16; unit += gridDim.x) {
        const int b = unit >> 4, chunk = unit & 15;
        const bf16_t* vt = VT + (size_t)b * 1024 * SEQ + chunk * 128;
        {
            const int pg = tid & 15, c0 = tid >> 4;
            float s[8], q[8];
#pragma unroll
            for (int j = 0; j < 8; ++j) { s[j] = 0.f; q[j] = 0.f; }
#pragma unroll 1
            for (int half = 0; half < 2; ++half) {
                u32x4 wv[16];
#pragma unroll
                for (int i = 0; i < 16; ++i) wv[i] = *(const u32x4*)(vt + (size_t)(c0 + 32 * (half * 16 + i)) * SEQ + pg * 8);
                asm volatile("s_waitcnt vmcnt(0)" ::: "memory");
#pragma unroll
                for (int i = 0; i < 16; ++i) {
                    const u32x4 w = wv[i];
                    const float v0 = bf_lo(w.x), v1 = bf_hi(w.x), v2 = bf_lo(w.y), v3 = bf_hi(w.y), v4 = bf_lo(w.z), v5 = bf_hi(w.z), v6 = bf_lo(w.w), v7 = bf_hi(w.w);
                    s[0] += v0; s[1] += v1; s[2] += v2; s[3] += v3; s[4] += v4; s[5] += v5; s[6] += v6; s[7] += v7;
                    q[0] += v0 * v0; q[1] += v1 * v1; q[2] += v2 * v2; q[3] += v3 * v3; q[4] += v4 * v4; q[5] += v5 * v5; q[6] += v6 * v6; q[7] += v7 * v7;
                }
            }
#pragma unroll
            for (int j = 0; j < 8; ++j) { s[j] += __shfl_xor(s[j], 16); s[j] += __shfl_xor(s[j], 32); q[j] += __shfl_xor(q[j], 16); q[j] += __shfl_xor(q[j], 32); }
            if (lane < 16) {
#pragma unroll
                for (int j = 0; j < 8; ++j) { red[(wave * 128 + pg * 8 + j) * 2] = s[j]; red[(wave * 128 + pg * 8 + j) * 2 + 1] = q[j]; }
            }
        }
        __syncthreads();
        if (tid < 128) {
            float s = 0.f, q = 0.f;
#pragma unroll
            for (int w = 0; w < 8; ++w) { s += red[(w * 128 + tid) * 2]; q += red[(w * 128 + tid) * 2 + 1]; }
            const float mean = s * (1.0f / 1024.0f); const float var = fmaxf(q * (1.0f / 1024.0f) - mean * mean, 0.f);
            stat[tid * 2] = mean; stat[tid * 2 + 1] = __builtin_amdgcn_rsqf(var + EPS);
        }
        __syncthreads();
        const int qrow = 16 * wave + fr;
        const size_t tok = (size_t)b * SEQ + chunk * 128 + qrow;
        LAS unsigned char* vbuf = lds + 32768;
        u32x4 wA[4]; u32x4 tl[4]; u32x4 uw[4];
#define SGU_G(d_) ((((d_) & 3) << 2) | ((-((d_) >> 5)) & 3))
#define SGU_LOAD(h_) do { const bf16_t* wsrow_ = WSB + ((size_t)(h_) * 128 + qrow) * 128 + 8 * fq; const bf16_t* up_ = U + tok * DM + (h_) * 128 + 32 * fq; \
            _Pragma("unroll") for (int ks = 0; ks < 4; ++ks) wA[ks] = *(const u32x4*)(wsrow_ + 32 * ks); \
            _Pragma("unroll") for (int i = 0; i < 4; ++i) { const int id_ = tid + 512 * i; tl[i] = *(const u32x4*)(vt + (size_t)((h_) * 128 + (id_ >> 4)) * SEQ + (id_ & 15) * 8); } \
            _Pragma("unroll") for (int n2 = 0; n2 < 4; ++n2) uw[n2] = *(const u32x4*)(up_ + 8 * n2); } while (0)
        SGU_LOAD(0);
#pragma unroll 1
        for (int h = 0; h < 8; ++h) {
            LAS unsigned char* vb = vbuf + (h & 1) * 32768;
#pragma unroll
            for (int i = 0; i < 4; ++i) { const int id_ = tid + 512 * i, d_ = id_ >> 4, c_ = id_ & 15; *(LAS u32x4*)(vb + d_ * 256 + ((c_ ^ SGU_G(d_)) << 4)) = tl[i]; }
            u32x4 wcur[4], ucur[4];
#pragma unroll
            for (int i = 0; i < 4; ++i) { wcur[i] = wA[i]; ucur[i] = uw[i]; }
            __syncthreads();
            if (h < 7) SGU_LOAD(h + 1);
            bf16x8 Af[4]; float c1 = 0.f, c2 = 0.f;
            f32x4 sv[16];
#pragma unroll
            for (int i = 0; i < 16; ++i) sv[i] = *(const LAS f32x4*)(stat + (32 * (i >> 2) + 8 * fq + 2 * (i & 3)) * 2);
            asm volatile("s_waitcnt lgkmcnt(0)" ::: "memory");
#pragma unroll
            for (int ks = 0; ks < 4; ++ks) {
                const u32x4 w = wcur[ks];
                float a[8] = {bf_lo(w.x), bf_hi(w.x), bf_lo(w.y), bf_hi(w.y), bf_lo(w.z), bf_hi(w.z), bf_lo(w.w), bf_hi(w.w)};
                unsigned pk[4];
#pragma unroll
                for (int j = 0; j < 8; j += 2) {
                    const f32x4 st4 = sv[ks * 4 + (j >> 1)];
                    const float m0 = st4[0], r0 = st4[1], m1 = st4[2], r1 = st4[3];
                    const unsigned pw = cvt_pk_bf16(a[j] * r0, a[j + 1] * r1);
                    c1 += bf_lo(pw) * m0 + bf_hi(pw) * m1; c2 += a[j] + a[j + 1];
                    pk[j >> 1] = pw;
                }
                u32x4 t; t.x = pk[0]; t.y = pk[1]; t.z = pk[2]; t.w = pk[3];
                Af[ks] = __builtin_bit_cast(bf16x8, t);
            }
            c1 += __shfl_xor(c1, 16); c1 += __shfl_xor(c1, 32); c2 += __shfl_xor(c2, 16); c2 += __shfl_xor(c2, 32);
            f32x4 acc[8];
#pragma unroll
            for (int n = 0; n < 8; ++n) acc[n] = (f32x4){0.f, 0.f, 0.f, 0.f};
            const int dbase = 32 * (fr >> 2) + (fr & 3);
            const int gsw = (((fr & 3) << 2) | ((-(fr >> 2)) & 3));
#pragma unroll
            for (int half = 0; half < 2; ++half) {
                bf16x8 bfr[2][8];
#pragma unroll
                for (int k2 = 0; k2 < 2; ++k2)
#pragma unroll
                    for (int n = 0; n < 8; ++n) bfr[k2][n] = *(const LAS bf16x8*)(vb + (dbase + 4 * n) * 256 + (((4 * (half * 2 + k2) + fq) ^ gsw) << 4));
                asm volatile("s_waitcnt lgkmcnt(0)" ::: "memory");
#pragma unroll
                for (int k2 = 0; k2 < 2; ++k2)
#pragma unroll
                    for (int n = 0; n < 8; ++n) acc[n] = __builtin_amdgcn_mfma_f32_16x16x32_bf16(bfr[k2][n], Af[half * 2 + k2], acc[n], 0, 0, 0);
            }
            const float bsv = gbl[2048 + h * 128 + qrow];
            const int ch0 = h * 128 + 32 * fq;
            bf16_t* up = U + tok * DM + ch0;
#pragma unroll
            for (int n2 = 0; n2 < 4; ++n2) {
                const u32x4 uwv = ucur[n2];
                const f32x4 g0 = *(const LAS f32x4*)(gbl + ch0 + 8 * n2), g1 = *(const LAS f32x4*)(gbl + ch0 + 8 * n2 + 4);
                const f32x4 b0 = *(const LAS f32x4*)(gbl + 1024 + ch0 + 8 * n2), b1 = *(const LAS f32x4*)(gbl + 1024 + ch0 + 8 * n2 + 4);
                const f32x4 a0 = acc[2 * n2], a1 = acc[2 * n2 + 1];
                float o[8];
                o[0] = bf_lo(uwv.x) * (g0[0] * (a0[0] - c1) + b0[0] * c2 + bsv); o[1] = bf_hi(uwv.x) * (g0[1] * (a0[1] - c1) + b0[1] * c2 + bsv);
                o[2] = bf_lo(uwv.y) * (g0[2] * (a0[2] - c1) + b0[2] * c2 + bsv); o[3] = bf_hi(uwv.y) * (g0[3] * (a0[3] - c1) + b0[3] * c2 + bsv);
                o[4] = bf_lo(uwv.z) * (g1[0] * (a1[0] - c1) + b1[0] * c2 + bsv); o[5] = bf_hi(uwv.z) * (g1[1] * (a1[1] - c1) + b1[1] * c2 + bsv);
                o[6] = bf_lo(uwv.w) * (g1[2] * (a1[2] - c1) + b1[2] * c2 + bsv); o[7] = bf_hi(uwv.w) * (g1[3] * (a1[3] - c1) + b1[3] * c2 + bsv);
                u32x4 w; w.x = cvt_pk_bf16(o[0], o[1]); w.y = cvt_pk_bf16(o[2], o[3]); w.z = cvt_pk_bf16(o[4], o[5]); w.w = cvt_pk_bf16(o[6], o[7]);
                *(u32x4*)(up + 8 * n2) = w;
            }
        }
#undef SGU_LOAD
#undef SGU_G
        __syncthreads();
    }
}

__device__ __forceinline__ void final_norm() {
    KParams KP = get_params();
    int tid_ = threadIdx.x; asm volatile("" : "+v"(tid_));
    const int tid = tid_, lane = tid & 63, gw = blockIdx.x * 8 + (tid >> 6), NGW = gridDim.x * 8;
    const float* rsa = (const float*)(KP->ws + WS_RSA); const float* gf = KP->in[13]; float* outp = KP->out; const bf16_t* xb = (const bf16_t*)(KP->ws + WS_XB);
    const f32x4 g0 = *(const f32x4*)(gf + lane * 16), g1 = *(const f32x4*)(gf + lane * 16 + 4), g2 = *(const f32x4*)(gf + lane * 16 + 8), g3 = *(const f32x4*)(gf + lane * 16 + 12);
    for (int row0 = gw * 4; row0 < T_TOK; row0 += NGW * 4) {
        float sv[4]; u32x4 w0[4], w1[4];
#pragma unroll
        for (int r = 0; r < 4; ++r) { const int row = row0 + r; sv[r] = rsa[(size_t)row * 16 + (lane & 15)];
            w0[r] = *(const u32x4*)(xb + (size_t)row * DM + lane * 16); w1[r] = *(const u32x4*)(xb + (size_t)row * DM + lane * 16 + 8); }
#pragma unroll
        for (int r = 0; r < 4; ++r) {
            float s = sv[r];
            s += __shfl_xor(s, 1); s += __shfl_xor(s, 2); s += __shfl_xor(s, 4); s += __shfl_xor(s, 8);
            const float rs = __builtin_amdgcn_rsqf(s * (1.0f / 1024.0f) + EPS);
            float* xr = outp + (size_t)(row0 + r) * DM + lane * 16;
            f32x4 a = {bf_lo(w0[r].x), bf_hi(w0[r].x), bf_lo(w0[r].y), bf_hi(w0[r].y)}, b = {bf_lo(w0[r].z), bf_hi(w0[r].z), bf_lo(w0[r].w), bf_hi(w0[r].w)};
            f32x4 c = {bf_lo(w1[r].x), bf_hi(w1[r].x), bf_lo(w1[r].y), bf_hi(w1[r].y)}, d = {bf_lo(w1[r].z), bf_hi(w1[r].z), bf_lo(w1[r].w), bf_hi(w1[r].w)};
            a = a * rs * g0; b = b * rs * g1; c = c * rs * g2; d = d * rs * g3;
            *(f32x4*)xr = a; *(f32x4*)(xr + 4) = b; *(f32x4*)(xr + 8) = c; *(f32x4*)(xr + 12) = d;
        }
    }
}

__global__ void __launch_bounds__(512, 2) fwd_kernel(Params P_unused) {
    extern __shared__ __attribute__((aligned(16))) unsigned char smem[];
    LAS unsigned char* lds = (LAS unsigned char*)smem;
    cg::grid_group grid = cg::this_grid();

    grid_barrier_post(lds);
    prologue(lds);
    grid.sync();

#pragma unroll 1
    for (int l = 0; l < DEPTH; ++l) {
        { KParams KP = get_params(); unsigned char* ws = KP->ws; const bf16_t* Win = (const bf16_t*)(ws + WS_WIN) + (size_t)l * INC * DM;
          pg8::Gemm g{(const bf16_t*)(ws + WS_XB), Win}; pg8::StaticOrder<T_TOK, 1536> S; S.init(gridDim.x, blockIdx.x);
          EpiInT E{}; pg8::gemm_phase<EpiInT, true, T_TOK, 1536, DM>(lds, g, S, E); }
        { KParams KP = get_params(); unsigned char* ws = KP->ws; const bf16_t* Win = (const bf16_t*)(ws + WS_WIN) + (size_t)l * INC * DM;
          pg8::Gemm g{(const bf16_t*)(ws + WS_XB), Win + (size_t)1536 * DM}; pg8::StaticOrder<T_TOK, 3072> S; S.init(gridDim.x, blockIdx.x);
          EpiIn E{}; pg8::gemm_phase<EpiIn, true, T_TOK, 3072, DM>(lds, g, S, E); }
        grid_barrier(lds);
        { KParams KP = get_params(); unsigned char* ws = KP->ws;
          pg8::Gemm g{(const bf16_t*)(ws + WS_CS), (const bf16_t*)(ws + WS_AINT)}; pg8::StaticOrder<SEQ, NBATCH * 512> S; S.init(gridDim.x, blockIdx.x);
          EpiDft E{}; pg8::gemm_phase<EpiDft, true, SEQ, NBATCH * 512, SEQ>(lds, g, S, E); }
        sgu_phase(lds, l);
        grid_barrier(lds);
        { KParams KP = get_params(); unsigned char* ws = KP->ws;
          pg8::Gemm g{(const bf16_t*)(ws + WS_YA), (const bf16_t*)(ws + WS_WACS) + (size_t)l * DM * DM, (const bf16_t*)(ws + WS_U), (const bf16_t*)(ws + WS_WB) + (size_t)l * DM * DM};
          pg8::StaticOrder<T_TOK, DM> S; S.init(gridDim.x, blockIdx.x);
          EpiGateM E{}; pg8::gemm_phase<EpiGateM, true, T_TOK, DM, 2 * DM, DM, DM / 64>(lds, g, S, E); }
        grid_barrier(lds);
        { KParams KP = get_params(); unsigned char* ws = KP->ws;
          pg8::Gemm g{(const bf16_t*)(ws + WS_MRG), (const bf16_t*)(ws + WS_WOUT) + (size_t)l * DM * DM}; pg8::StaticOrder<T_TOK, DM> S; S.init(gridDim.x, blockIdx.x);
          EpiRes E{true}; pg8::gemm_phase<EpiRes, true, T_TOK, DM, DM>(lds, g, S, E); }
        grid_barrier(lds);
        { KParams KP = get_params(); unsigned char* ws = KP->ws;
          pg8::Gemm g{(const bf16_t*)(ws + WS_XB), (const bf16_t*)(ws + WS_WUP) + (size_t)l * DFF * DM}; pg8::StaticOrder<T_TOK, DFF> S; S.init(gridDim.x, blockIdx.x);
          EpiUp E{}; pg8::gemm_phase<EpiUp, true, T_TOK, DFF, DM>(lds, g, S, E); }
        grid_barrier(lds);
        { KParams KP = get_params(); unsigned char* ws = KP->ws;
          pg8::Gemm g{(const bf16_t*)(ws + WS_F), (const bf16_t*)(ws + WS_WDN) + (size_t)l * DM * DFF}; pg8::StaticOrder<T_TOK, DM> S; S.init(gridDim.x, blockIdx.x);
          EpiRes E{false}; pg8::gemm_phase<EpiRes, true, T_TOK, DM, DFF>(lds, g, S, E); }
        grid_barrier(lds);
    }
    final_norm();
}

extern "C" void kernel_launch(void* const* d_in, const int* in_sizes, int n_in, void* d_out, int out_size, void* d_ws, size_t ws_size, hipStream_t stream) {
    constexpr int LDS_BYTES = pg8::STAGE_BYTES + 64;
    static int grid_blocks = 0;
    if (grid_blocks == 0) {
        if (n_in != 14 || out_size != T_TOK * DM || ws_size < WS_END) { fprintf(stderr, "kernel_launch: unexpected shapes (n_in %d out %d ws %zu need %zu)\n", n_in, out_size, ws_size, (size_t)WS_END); grid_blocks = -1; return; }
        int dev = 0, cus = 0, per_cu = 0;
        hipGetDevice(&dev);
        hipDeviceGetAttribute(&cus, hipDeviceAttributeMultiprocessorCount, dev);
        if (hipFuncSetAttribute((const void*)fwd_kernel, hipFuncAttributeMaxDynamicSharedMemorySize, LDS_BYTES) != hipSuccess) { fprintf(stderr, "kernel_launch: hipFuncSetAttribute failed\n"); grid_blocks = -1; return; }
        if (hipOccupancyMaxActiveBlocksPerMultiprocessor(&per_cu, (const void*)fwd_kernel, 512, LDS_BYTES) != hipSuccess || per_cu < 1) { fprintf(stderr, "kernel_launch: occupancy query says %d blocks per CU\n", per_cu); per_cu = 1; }
        (void)hipGetLastError();
        grid_blocks = cus;
    }
    if (grid_blocks < 0) return;
    if (hipMemsetAsync((char*)d_ws + WS_BAR, 0, WS_BAR_BYTES, stream) != hipSuccess) { fprintf(stderr, "kernel_launch: memset of the barrier words failed\n"); return; }
    Params p{};
    for (int i = 0; i < 14; ++i) p.in[i] = (const float*)d_in[i];
    p.out = (float*)d_out; p.ws = (unsigned char*)d_ws;
    void* args[] = {&p};
    hipError_t e = hipLaunchCooperativeKernel((const void*)fwd_kernel, dim3(grid_blocks), dim3(512), args, LDS_BYTES, stream);
    if (e != hipSuccess) fprintf(stderr, "cooperative launch failed: %s (grid %d)\n", hipGetErrorString(e), grid_blocks);
}
```
